# Optimizing an MI355X kernel written in HIP

```python
import jax, jax.numpy as jnp
from jax import lax
import numpy as np

D_MODEL = 2048
BATCH = 2
SEQ = 4096
DEPTH = 4

GRID_W = 64
CTX_LEN = 256
NA_HEADS = 8
NA_HEAD_DIM = 128
NA_WIDTH = NA_HEADS * NA_HEAD_DIM
WIN_R = 8
WIN_C = 16
ROPE_BASE = 10000.0
SSD_HEADS = 16
SSD_HEAD_DIM = 64
SSD_INNER = SSD_HEADS * SSD_HEAD_DIM
SSD_GROUPS = 2
SSD_STATE = 128
SSD_CHUNK = 128
CONV_K = 5
CONV_CH = SSD_INNER + 2 * SSD_GROUPS * SSD_STATE
IN_W = 3 * NA_WIDTH + SSD_INNER + CONV_CH + 2 * SSD_HEADS
MIX_W = NA_WIDTH + SSD_INNER
F_GROUPS = 4
D_FF = 5632
N_MOD = 9
N_EVEN = (DEPTH + 1) // 2
N_ODD = DEPTH // 2
EPS = 1e-6

kernel_name = 'hybrid_natten_ssd_fnet_macaron_dit'


def rms_norm(x, g):
    xf = x.astype(jnp.float32)
    y = xf * lax.rsqrt(jnp.mean(xf * xf, axis=-1, keepdims=True) + EPS)
    return (y * g.astype(jnp.float32)).astype(x.dtype)


def modulate(x, g, shift, scale):
    return rms_norm(x, g) * (1 + scale) + shift


def swiglu(h, w1, w3, w2):
    return (jax.nn.silu(h @ w1) * (h @ w3)) @ w2


def axial_rope(x, row, col):
    quarter = x.shape[-1] // 4
    inv_freq = ROPE_BASE ** (-jnp.arange(quarter, dtype=jnp.float32) / quarter)

    def rotate(xa, pos):
        ang = pos.astype(jnp.float32)[:, None] * inv_freq[None, :]
        cos = jnp.cos(ang)[None, :, None, :]
        sin = jnp.sin(ang)[None, :, None, :]
        x1, x2 = jnp.split(xa.astype(jnp.float32), 2, axis=-1)
        return jnp.concatenate([x1 * cos - x2 * sin, x2 * cos + x1 * sin], axis=-1)

    xr, xc = jnp.split(x, 2, axis=-1)
    return jnp.concatenate([rotate(xr, row), rotate(xc, col)], axis=-1).astype(x.dtype)


def neighbourhood_attention(q, k, v, kc, vc, rpb, row, col):
    bsz, L, H, dh = q.shape
    rows = L // GRID_W
    wr = min(WIN_R, rows)
    scale = dh ** -0.5
    qg = axial_rope(q, row, col).reshape(bsz, rows, GRID_W, H, dh)
    kg = axial_rope(k, row, col).reshape(bsz, rows, GRID_W, H, dh)
    vg = v.reshape(bsz, rows, GRID_W, H, dh)
    r = jnp.arange(rows)
    r0 = jnp.clip(r - wr // 2, 0, rows - wr)
    row_idx = r0[:, None] + jnp.arange(wr)[None, :]
    kb = kg[:, row_idx]
    vb = vg[:, row_idx]
    s_win = jnp.einsum('brqhd,brwkhd->bhrqwk', qg, kb).astype(jnp.float32) * scale
    cq = jnp.arange(GRID_W)
    c0 = jnp.clip(cq - WIN_C // 2, 0, GRID_W - WIN_C)
    col_ok = (cq[None, :] >= c0[:, None]) & (cq[None, :] < c0[:, None] + WIN_C)
    dr = row_idx - r[:, None] + (WIN_R - 1)
    dc = jnp.clip(cq[None, :] - cq[:, None], -(WIN_C - 1), WIN_C - 1) + (WIN_C - 1)
    bias = rpb.astype(jnp.float32)[:, dr[:, None, :, None], dc[None, :, None, :]]
    s_win = jnp.where(col_ok[:, None, :], s_win + bias, -jnp.inf)
    q_plain = q.reshape(bsz, rows, GRID_W, H, dh)
    s_ctx = jnp.einsum('brqhd,bchd->bhrqc', q_plain, kc).astype(jnp.float32) * scale
    n_win = wr * GRID_W
    logits = jnp.concatenate([s_win.reshape(bsz, H, rows, GRID_W, n_win), s_ctx], axis=-1)
    p = jax.nn.softmax(logits, axis=-1).astype(v.dtype)
    p_win = p[..., :n_win].reshape(bsz, H, rows, GRID_W, wr, GRID_W)
    p_ctx = p[..., n_win:]
    o = jnp.einsum('bhrqwk,brwkhd->brqhd', p_win, vb) + jnp.einsum('bhrqc,bchd->brqhd', p_ctx, vc)
    return o.reshape(bsz, L, H * dh)


def context_attention(qc, kc, vc):
    bsz, lc, H, dh = qc.shape
    s = jnp.einsum('bqhd,bkhd->bhqk', qc, kc).astype(jnp.float32) * dh ** -0.5
    p = jax.nn.softmax(s, axis=-1).astype(vc.dtype)
    return jnp.einsum('bhqk,bkhd->bqhd', p, vc).reshape(bsz, lc, H * dh)


def centred_dwconv(x, w, b):
    y = lax.conv_general_dilated(x, w[:, None, :].astype(x.dtype), window_strides=(1,),
                                 padding=[(CONV_K // 2, CONV_K // 2)],
                                 dimension_numbers=('NWC', 'WIO', 'NWC'),
                                 feature_group_count=x.shape[-1])
    return y + b.astype(x.dtype)


def ssd_chunked(x, dt, A, bm, cm, h0, with_y):
    bsz, L, H, P = x.shape
    Q = SSD_CHUNK
    nc = L // Q
    rep = H // SSD_GROUPS
    f32 = jnp.float32
    xq = x.astype(f32).reshape(bsz, nc, Q, H, P)
    dtq = dt.reshape(bsz, nc, Q, H)
    bh = jnp.repeat(bm.astype(f32), rep, axis=2).reshape(bsz, nc, Q, H, SSD_STATE)
    ch = jnp.repeat(cm.astype(f32), rep, axis=2).reshape(bsz, nc, Q, H, SSD_STATE)
    a_cum = jnp.cumsum(dtq * A.astype(f32), axis=2)
    xdt = xq * dtq[..., None]
    a_end = a_cum[:, :, -1]
    states = jnp.einsum('bcjhn,bcjhp->bchpn', bh * jnp.exp(a_end[:, :, None] - a_cum)[..., None], xdt)

    def step(h, inp):
        dec, s = inp
        return dec[:, :, None, None] * h + s, h

    h_fin, h_in = lax.scan(step, h0, (jnp.moveaxis(jnp.exp(a_end), 1, 0), jnp.moveaxis(states, 1, 0)))
    if not with_y:
        return None, h_fin
    h_in = jnp.moveaxis(h_in, 0, 1)
    seg = a_cum[:, :, :, None, :] - a_cum[:, :, None, :, :]
    lower = jnp.tril(jnp.ones((Q, Q), dtype=bool))[None, None, :, :, None]
    decay = jnp.exp(jnp.where(lower, seg, -jnp.inf))
    scores = jnp.einsum('bcihn,bcjhn->bcijh', ch, bh) * decay
    y = (jnp.einsum('bcijh,bcjhp->bcihp', scores, xdt)
         + jnp.einsum('bcihn,bchpn->bcihp', ch * jnp.exp(a_cum)[..., None], h_in))
    return y.reshape(bsz, L, H, P), h_fin


def ssd_bidirectional(xbc, dt_raw, h0_f, h0_b, conv_w, conv_b, dt_bias, a_log, d_skip, with_y):
    xbc = jax.nn.silu(centred_dwconv(xbc, conv_w, conv_b))
    bsz, L, _ = xbc.shape
    gn = SSD_GROUPS * SSD_STATE
    xs = xbc[..., :SSD_INNER].reshape(bsz, L, SSD_HEADS, SSD_HEAD_DIM)
    bm = xbc[..., SSD_INNER:SSD_INNER + gn].reshape(bsz, L, SSD_GROUPS, SSD_STATE)
    cm = xbc[..., SSD_INNER + gn:].reshape(bsz, L, SSD_GROUPS, SSD_STATE)
    A = -jnp.exp(a_log.astype(jnp.float32))
    dt = jax.nn.softplus(dt_raw.astype(jnp.float32).reshape(bsz, L, 2, SSD_HEADS) + dt_bias.astype(jnp.float32))
    flip = lambda t: jnp.flip(t, axis=1)
    y_f, h_f = ssd_chunked(xs, dt[:, :, 0], A[0], bm, cm, h0_f, with_y)
    y_b, h_b = ssd_chunked(flip(xs), flip(dt[:, :, 1]), A[1], flip(bm), flip(cm), h0_b, with_y)
    if not with_y:
        return None, h_f, h_b
    y = y_f + flip(y_b) + d_skip.astype(jnp.float32)[:, None] * xs.astype(jnp.float32)
    return y.reshape(bsz, L, SSD_INNER), h_f, h_b


def gated_rmsnorm(y, z, g):
    yz = y.astype(jnp.float32) * jax.nn.silu(z.astype(jnp.float32))
    bsz, L, _ = yz.shape
    yg = yz.reshape(bsz, L, SSD_GROUPS, SSD_INNER // SSD_GROUPS)
    yg = yg * lax.rsqrt(jnp.mean(yg * yg, axis=-1, keepdims=True) + EPS)
    return (yg.reshape(bsz, L, SSD_INNER) * g.astype(jnp.float32)).astype(z.dtype)


def even_mixer(h, hc, row, col, w_in, w_out, qk_g, rpb, conv_w, conv_b, dt_bias, a_log, d_skip, ssd_g, ctx_out):
    cuts = [NA_WIDTH, 2 * NA_WIDTH, 3 * NA_WIDTH, 3 * NA_WIDTH + SSD_INNER, 3 * NA_WIDTH + SSD_INNER + CONV_CH]
    q, k, v, z, xbc, dt = jnp.split(h @ w_in, cuts, axis=-1)
    qc, kc, vc, zc, xbcc, dtc = jnp.split(hc @ w_in, cuts, axis=-1)
    heads = lambda t: t.reshape(t.shape[0], t.shape[1], NA_HEADS, NA_HEAD_DIM)
    q, k, v = rms_norm(heads(q), qk_g[0]), rms_norm(heads(k), qk_g[1]), heads(v)
    qc, kc, vc = rms_norm(heads(qc), qk_g[0]), rms_norm(heads(kc), qk_g[1]), heads(vc)
    attn = neighbourhood_attention(q, k, v, kc, vc, rpb, row, col)
    h0 = jnp.zeros((hc.shape[0], SSD_HEADS, SSD_HEAD_DIM, SSD_STATE), jnp.float32)
    yc_ssd, hf, hb = ssd_bidirectional(xbcc, dtc, h0, h0, conv_w, conv_b, dt_bias, a_log, d_skip, ctx_out)
    y_ssd, _, _ = ssd_bidirectional(xbc, dt, hf, hb, conv_w, conv_b, dt_bias, a_log, d_skip, True)
    out = jnp.concatenate([attn, gated_rmsnorm(y_ssd, z, ssd_g)], axis=-1) @ w_out
    if not ctx_out:
        return out, None
    attn_c = context_attention(qc, kc, vc)
    out_c = jnp.concatenate([attn_c, gated_rmsnorm(yc_ssd, zc, ssd_g)], axis=-1) @ w_out
    return out, out_c


def fourier_mix(h, w):
    bsz, L, dm = h.shape
    hg = h.astype(jnp.float32).reshape(bsz, L, F_GROUPS, dm // F_GROUPS)
    f = jnp.fft.fft2(hg, axes=(1, 3), norm='ortho').real
    return f.reshape(bsz, L, dm).astype(h.dtype) @ w


def setup_inputs(seed: int = 0) -> dict:
    key = jax.random.key(seed)
    ks = jax.random.split(key, 24)
    nrm = lambda k, shape, s: jax.random.normal(k, shape, jnp.float32) * s
    dt0 = jnp.exp(jax.random.uniform(ks[17], (N_EVEN, 2, SSD_HEADS), jnp.float32)
                  * (np.log(0.1) - np.log(0.001)) + np.log(0.001))
    return {
        'x': nrm(ks[0], (BATCH, SEQ, D_MODEL), 1.0),
        'c': nrm(ks[1], (BATCH, D_MODEL), 1.0),
        'ctx': nrm(ks[2], (BATCH, CTX_LEN, D_MODEL), 1.0),
        'c_ctx': nrm(ks[3], (D_MODEL,), 1.0),
        'mod_w': nrm(ks[4], (DEPTH, D_MODEL, N_MOD * D_MODEL), 0.25 * D_MODEL ** -0.5),
        'mod_b': nrm(ks[5], (DEPTH, N_MOD * D_MODEL), 0.02),
        'norm_g': 1.0 + nrm(ks[6], (DEPTH, 3, D_MODEL), 0.02),
        'ffn_w1': nrm(ks[7], (DEPTH, 2, D_MODEL, D_FF), D_MODEL ** -0.5),
        'ffn_w3': nrm(ks[8], (DEPTH, 2, D_MODEL, D_FF), D_MODEL ** -0.5),
        'ffn_w2': nrm(ks[9], (DEPTH, 2, D_FF, D_MODEL), D_FF ** -0.5),
        'mix_w_in': nrm(ks[10], (N_EVEN, D_MODEL, IN_W), D_MODEL ** -0.5),
        'mix_w_out': nrm(ks[11], (N_EVEN, MIX_W, D_MODEL), MIX_W ** -0.5),
        'qk_g': 1.0 + nrm(ks[12], (N_EVEN, 2, NA_HEAD_DIM), 0.02),
        'rpb': nrm(ks[13], (N_EVEN, NA_HEADS, 2 * WIN_R - 1, 2 * WIN_C - 1), 0.1),
        'conv_w': nrm(ks[14], (N_EVEN, CONV_K, CONV_CH), CONV_K ** -0.5),
        'conv_b': nrm(ks[15], (N_EVEN, CONV_CH), 0.02),
        'dt_bias': dt0 + jnp.log(-jnp.expm1(-dt0)),
        'a_log': jnp.log(jax.random.uniform(ks[18], (N_EVEN, 2, SSD_HEADS), jnp.float32, 1.0, 16.0)),
        'ssd_d': 1.0 + nrm(ks[19], (N_EVEN, SSD_HEADS), 0.1),
        'ssd_norm_g': 1.0 + nrm(ks[20], (N_EVEN, SSD_INNER), 0.02),
        'fourier_w': nrm(ks[21], (N_ODD, D_MODEL, D_MODEL), D_MODEL ** -0.5),
    }


def reference(x, c, ctx, c_ctx, mod_w, mod_b, norm_g, ffn_w1, ffn_w3, ffn_w2, mix_w_in, mix_w_out, qk_g, rpb,
              conv_w, conv_b, dt_bias, a_log, ssd_d, ssd_norm_g, fourier_w):
    L = x.shape[1]
    t = jnp.arange(L)
    row = t // GRID_W
    col = t % GRID_W
    last_ctx = ((DEPTH - 1) // 2) * 2
    xc = ctx
    for i in range(DEPTH):
        use_ctx = i <= last_ctx
        ctx_out = i < last_ctx
        j = i // 2
        m = jnp.split((jax.nn.silu(c) @ mod_w[i] + mod_b[i])[:, None, :], N_MOD, axis=-1)
        x = x + 0.5 * m[2] * swiglu(modulate(x, norm_g[i, 0], m[0], m[1]), ffn_w1[i, 0], ffn_w3[i, 0], ffn_w2[i, 0])
        h = modulate(x, norm_g[i, 1], m[3], m[4])
        hc = None
        mc = None
        if use_ctx:
            mc = jnp.split(jax.nn.silu(c_ctx) @ mod_w[i] + mod_b[i], N_MOD, axis=-1)
            xc = xc + 0.5 * mc[2] * swiglu(modulate(xc, norm_g[i, 0], mc[0], mc[1]), ffn_w1[i, 0], ffn_w3[i, 0], ffn_w2[i, 0])
            hc = modulate(xc, norm_g[i, 1], mc[3], mc[4])
        if i % 2 == 0:
            mix, mix_c = even_mixer(h, hc, row, col, mix_w_in[j], mix_w_out[j], qk_g[j], rpb[j], conv_w[j], conv_b[j],
                                    dt_bias[j], a_log[j], ssd_d[j], ssd_norm_g[j], ctx_out)
        else:
            mix = fourier_mix(h, fourier_w[j])
            mix_c = fourier_mix(hc, fourier_w[j]) if ctx_out else None
        x = x + m[5] * mix
        x = x + 0.5 * m[8] * swiglu(modulate(x, norm_g[i, 2], m[6], m[7]), ffn_w1[i, 1], ffn_w3[i, 1], ffn_w2[i, 1])
        if ctx_out:
            xc = xc + mc[5] * mix_c
            xc = xc + 0.5 * mc[8] * swiglu(modulate(xc, norm_g[i, 2], mc[6], mc[7]), ffn_w1[i, 1], ffn_w3[i, 1], ffn_w2[i, 1])
    return x
```

```cpp
#include <hip/hip_runtime.h>
#include <stdint.h>
#include <cstdio>
namespace pg8 {
#define PG8_LAS __attribute__((address_space(3)))
typedef unsigned short bf16_t;
typedef short bf16x8 __attribute__((ext_vector_type(8)));
typedef float f32x4 __attribute__((ext_vector_type(4)));
typedef float f32x2 __attribute__((ext_vector_type(2)));
typedef unsigned u32x4 __attribute__((ext_vector_type(4)));
typedef unsigned u32x2 __attribute__((ext_vector_type(2)));
constexpr int BM = 256, BK = 64, HALF = 128, HTB = HALF * BK * 2  , STAGE_BYTES = 8 * HTB, NXCD = 8, WGM = 8;

__host__ __device__ __forceinline__ int lds_byte(int r, int c) { const int st = (r >> 4) * 2 + (c >> 5), rr = r & 15, cc = c & 31, ob = rr * 64 + cc * 2; return st * 1024 + (ob ^ (((ob >> 9) & 1) << 5)); }
__host__ __device__ __forceinline__ void stage_rc(int b, int& R, int& C) { const int st = b / 1024, sb = b % 1024, swz = sb ^ (((sb >> 9) & 1) << 5); R = (st >> 1) * 16 + swz / 64; C = (st & 1) * 32 + (swz % 64) / 2; }
__host__ __device__ __forceinline__ int perm32(int rho) { const int n = rho >> 4, i = rho & 15; return 8 * (i >> 2) + 4 * n + (i & 3); }

struct Unit { int pm, pn, pz; };
struct Gemm { const bf16_t* A; const bf16_t* Bt; int lda, ldb, K, zdiv; long zA1, zA2, zB1, zB2; long tsA, tsB; };

struct Order {
    int nM, nN, per, total, G, c;
    __host__ __device__ void init(int M, int N, int Z, int G_, int c_) { nM = M / BM; nN = N / BM; per = nM * nN; total = per * Z; G = G_; c = c_; }
    __host__ __device__ bool next(int i, Unit& u) const {
        const long L = (long)i * G + c; if (L >= total) return false;
        const int z = (int)(L / per); int wgid = (int)(L % per); { const int q = per / NXCD, r = per % NXCD, xcd = wgid % NXCD, off = wgid / NXCD; wgid = (xcd < r ? xcd * (q + 1) : r * (q + 1) + (xcd - r) * q) + off; }
        const int nig = WGM * nN, gid = wgid / nig, fm = gid * WGM, gsz = (nM - fm) < WGM ? (nM - fm) : WGM;
        u.pm = fm + ((wgid % nig) % gsz); u.pn = (wgid % nig) / gsz; u.pz = z; return true;
    }
};

typedef __bf16 bf16x2_t __attribute__((ext_vector_type(2)));
__device__ __forceinline__ unsigned cvt_pk_bf16(float lo, float hi) { const f32x2 v = {lo, hi}; const bf16x2_t b = __builtin_convertvector(v, bf16x2_t); return __builtin_bit_cast(unsigned, b); }

template <class Epi, bool ALIGN_EPI = true>
__device__ __forceinline__ void gemm_phase(PG8_LAS unsigned char* lds, const Gemm g, const Order& S, const Epi& E) {
    int tz_ = threadIdx.x; asm volatile("" : "+v"(tz_));
    const int tid = tz_, wid = __builtin_amdgcn_readfirstlane(tid >> 6), lane = tid & 63, wr = wid >> 2, wc = wid & 3, fr = lane & 15, fq = lane >> 4;
    const int K = g.K, nt = K / BK;
    unsigned voffA[2], voffB[2];
#pragma unroll
    for (int i = 0; i < 2; ++i) { int R, C; stage_rc(tid * 16 + i * 8192, R, C); const int Rb = Epi::PERM ? ((R & ~31) + perm32(R & 31)) : R;
        voffA[i] = (unsigned)(R * g.lda + C) * 2u; voffB[i] = (unsigned)(Rb * g.ldb + C) * 2u; }
    const size_t kstep = (size_t)(BK * 2);
    const size_t hstepA = (size_t)HALF * g.lda * 2, hstepB = (size_t)HALF * g.ldb * 2;
    const unsigned ldsw = (unsigned)wid * 1024u;
    const int aoff = lds_byte(wr * 64 + fr, fq * 8), boff = lds_byte(wc * 32 + fr, fq * 8);
#define PG8_SA(b, h) (((b) * 2 + (h)) * HTB)
#define PG8_SB(b, h) ((4 + (b) * 2 + (h)) * HTB)
#ifndef PG8_AUX_A
#define PG8_AUX_A 0
#endif
#ifndef PG8_AUX_B
#define PG8_AUX_B 0
#endif
#define PG8_STAGE(bufoff, gbase, voff) do { _Pragma("unroll") for (int _i = 0; _i < 2; ++_i) \
        __builtin_amdgcn_global_load_lds((const unsigned*)((const char*)(gbase) + (voff)[_i]), (PG8_LAS unsigned*)(lds + (bufoff) + ldsw + _i * 8192), 16, 0, ((bufoff) >= 4 * HTB ? PG8_AUX_B : PG8_AUX_A)); } while (0)
#define PG8_LDA(dst, b, h) do { _Pragma("unroll") for (int m = 0; m < 4; ++m) _Pragma("unroll") for (int k = 0; k < 2; ++k) dst[m][k] = *(const PG8_LAS bf16x8*)(lds + PG8_SA(b, h) + aoff + m * 2048 + k * 1024); } while (0)
#define PG8_LDB(dst, b, h) do { _Pragma("unroll") for (int n = 0; n < 2; ++n) _Pragma("unroll") for (int k = 0; k < 2; ++k) dst[n][k] = *(const PG8_LAS bf16x8*)(lds + PG8_SB(b, h) + boff + n * 2048 + k * 1024); } while (0)
#define PG8_MMA(ai, bj, At, Bt) do { __builtin_amdgcn_s_setprio(1); _Pragma("unroll") for (int m = 0; m < 4; ++m) _Pragma("unroll") for (int n = 0; n < 2; ++n) _Pragma("unroll") for (int k = 0; k < 2; ++k) \
        acc[ai][bj][m][n] = __builtin_amdgcn_mfma_f32_16x16x32_bf16(Bt[n][k], At[m][k], acc[ai][bj][m][n], 0, 0, 0); __builtin_amdgcn_s_setprio(0); } while (0)
#define PG8_WAIT_V(n) asm volatile("s_waitcnt vmcnt(" #n ")" ::: "memory")
#define PG8_WAIT_L(n) asm volatile("s_waitcnt lgkmcnt(" #n ")" ::: "memory")
#define PG8_BAR __builtin_amdgcn_s_barrier()
#define PG8_SCHED __builtin_amdgcn_sched_barrier(0)
#define PG8_BASEA(u) ((const char*)g.A + ((size_t)(u).pm * g.tsA + (size_t)((u).pz / g.zdiv) * g.zA1 + (size_t)((u).pz % g.zdiv) * g.zA2) * 2)
#define PG8_BASEB(u) ((const char*)g.Bt + ((size_t)(u).pn * g.tsB + (size_t)((u).pz / g.zdiv) * g.zB1 + (size_t)((u).pz % g.zdiv) * g.zB2) * 2)
    Unit cur, nxt; int ui = 0;
    if (!S.next(0, cur)) return;
    f32x4 acc[2][2][4][2];
#pragma unroll
    for (int a = 0; a < 2; ++a)
#pragma unroll
        for (int b = 0; b < 2; ++b)
#pragma unroll
            for (int m = 0; m < 4; ++m)
#pragma unroll
                for (int n = 0; n < 2; ++n) acc[a][b][m][n] = (f32x4){0.f, 0.f, 0.f, 0.f};
    bf16x8 At[4][2], B0[2][2], B1[2][2];
    const char* cA = PG8_BASEA(cur); const char* cB = PG8_BASEB(cur);
    PG8_STAGE(PG8_SB(0, 0), cB, voffB); PG8_STAGE(PG8_SB(0, 1), cB + hstepB, voffB); PG8_STAGE(PG8_SA(0, 0), cA, voffA); PG8_STAGE(PG8_SA(0, 1), cA + hstepA, voffA);
    if (wr == 1) PG8_BAR;
    PG8_WAIT_V(2); PG8_BAR;
    PG8_STAGE(PG8_SB(1, 0), cB + kstep, voffB); PG8_STAGE(PG8_SA(1, 0), cA + kstep, voffA); PG8_STAGE(PG8_SB(1, 1), cB + hstepB + kstep, voffB);
    PG8_WAIT_V(6); PG8_BAR;
    for (;;) {
        const bool has_next = S.next(ui + 1, nxt);
        const char* nA = has_next ? PG8_BASEA(nxt) : cA; const char* nB = has_next ? PG8_BASEB(nxt) : cB;
        for (int t = 0; t < nt; t += 2) {
            const bool last = (t == nt - 2);
            const char* a1 = cA + (size_t)(t + 1) * kstep;
            const char* a2 = last ? nA : cA + (size_t)(t + 2) * kstep; const char* b2 = last ? nB : cB + (size_t)(t + 2) * kstep;
            const char* a3 = a2 + kstep; const char* b3 = b2 + kstep;
            PG8_LDB(B0, 0, 0); PG8_LDB(B1, 0, 1); PG8_SCHED; PG8_LDA(At, 0, 0); PG8_STAGE(PG8_SA(1, 1), a1 + hstepA, voffA);
            PG8_WAIT_V(8); PG8_WAIT_L(0); PG8_BAR; PG8_MMA(0, 0, At, B0); PG8_MMA(0, 1, At, B1); PG8_BAR; PG8_SCHED;
            PG8_LDA(At, 0, 1); PG8_STAGE(PG8_SB(0, 0), b2, voffB); PG8_STAGE(PG8_SB(0, 1), b2 + hstepB, voffB); PG8_STAGE(PG8_SA(0, 0), a2, voffA);
            PG8_WAIT_V(8); PG8_WAIT_L(0); PG8_BAR; PG8_MMA(1, 0, At, B0); PG8_MMA(1, 1, At, B1); PG8_BAR; PG8_SCHED;
            PG8_LDB(B0, 1, 0); PG8_LDB(B1, 1, 1); PG8_SCHED; PG8_LDA(At, 1, 0); PG8_STAGE(PG8_SA(0, 1), a2 + hstepA, voffA);
            PG8_WAIT_V(8); PG8_WAIT_L(0); PG8_BAR; PG8_MMA(0, 0, At, B0); PG8_MMA(0, 1, At, B1); PG8_BAR; PG8_SCHED;
            PG8_LDA(At, 1, 1); PG8_STAGE(PG8_SB(1, 0), b3, voffB); PG8_STAGE(PG8_SB(1, 1), b3 + hstepB, voffB); PG8_STAGE(PG8_SA(1, 0), a3, voffA);
            PG8_WAIT_V(8); PG8_WAIT_L(0); PG8_BAR; PG8_MMA(1, 0, At, B0); PG8_MMA(1, 1, At, B1); PG8_BAR; PG8_SCHED;
        }
        if constexpr (ALIGN_EPI) { if (wr == 0) PG8_BAR; }
        E(acc, cur, wr, wc, fr, fq);
        if (!has_next) break;
#pragma unroll
        for (int a = 0; a < 2; ++a)
#pragma unroll
            for (int b = 0; b < 2; ++b)
#pragma unroll
                for (int m = 0; m < 4; ++m)
#pragma unroll
                    for (int n = 0; n < 2; ++n) acc[a][b][m][n] = (f32x4){0.f, 0.f, 0.f, 0.f};
        cur = nxt; cA = nA; cB = nB; ++ui;
        if constexpr (ALIGN_EPI) { if (wr == 1) PG8_BAR; }
    }
    PG8_WAIT_V(0);
    if constexpr (!ALIGN_EPI) { if (wr == 0) PG8_BAR; }
    PG8_BAR;
#undef PG8_SA
#undef PG8_SB
#undef PG8_STAGE
#undef PG8_LDA
#undef PG8_LDB
#undef PG8_MMA
#undef PG8_WAIT_V
#undef PG8_WAIT_L
#undef PG8_BAR
#undef PG8_SCHED
#undef PG8_BASEA
#undef PG8_BASEB
}
}

namespace mk {
using pg8::bf16_t; using pg8::bf16x8; using pg8::f32x4; using pg8::f32x2; using pg8::u32x4; using pg8::u32x2; using pg8::cvt_pk_bf16;
#define LAS __attribute__((address_space(3)))
constexpr int NWAVES = 8, NTHR = 512;
constexpr int D = 2048, SEQ = 4096, CTXL = 256, ML = 8192, MC = 512, MT = 8704, DFF = 5632, NMOD = 18432, INW = 5664, NPJ = 5632;
#ifndef MK_HP
#define MK_HP 5632
#endif
constexpr int HP = MK_HP;
#ifndef MK_NT_X
#define MK_NT_X 0
#endif
#ifndef MK_NT_PRO
#define MK_NT_PRO 1
#endif
constexpr float EPS = 1e-6f;
constexpr float LOG2E = 1.4426950408889634f;

constexpr size_t al256(size_t x) { return (x + 255) / 256 * 256; }
constexpr size_t WS_CTL = 0, CTL_ZERO_BYTES = 1u << 20;
constexpr size_t WS_MOD = WS_CTL + CTL_ZERO_BYTES;
constexpr size_t WS_ROPE = WS_MOD + al256((size_t)4 * 3 * NMOD * 4);
constexpr size_t WS_XR = WS_ROPE + al256(64 * 32 * 8);
constexpr size_t WS_XN = WS_XR + al256((size_t)MT * D * 4);
constexpr size_t WS_H = WS_XN + al256((size_t)MT * D * 2);
constexpr size_t WS_PROJ = WS_H + al256((size_t)MT * HP * 2);
constexpr size_t WS_QP = WS_PROJ + al256((size_t)MT * NPJ * 2);
constexpr size_t WS_QR = WS_QP + al256((size_t)MT * 1024 * 2);
constexpr size_t WS_KR = WS_QR + al256((size_t)MT * 1024 * 2);
constexpr size_t WS_XBC = WS_KR + al256((size_t)MT * (1024 + 64) * 2);
constexpr size_t WS_DT = WS_XBC + al256((size_t)MT * 1536 * 2);
constexpr size_t WS_DA = WS_DT + al256((size_t)MT * 32 * 4);
constexpr size_t WS_YF = WS_DA + al256((size_t)MT * 32 * 4);
constexpr size_t WS_YB = WS_YF + al256((size_t)MT * 1024 * 4);
constexpr size_t WS_MIX = WS_YB + al256((size_t)MT * 1024 * 4);
constexpr size_t WS_W13 = WS_MIX + al256((size_t)MT * D * 2);
constexpr size_t WS_W2 = WS_W13 + al256((size_t)8 * 2 * DFF * D * 2);
constexpr size_t WS_WIN = WS_W2 + al256((size_t)8 * D * HP * 2);
constexpr size_t WS_WDT = WS_WIN + al256((size_t)2 * NPJ * D * 2);
constexpr size_t WS_WOUT = WS_WDT + al256((size_t)2 * 32 * D * 2);
constexpr size_t WS_WF = WS_WOUT + al256((size_t)2 * D * D * 2);
constexpr size_t WS_DFTL = WS_WF + al256((size_t)2 * D * D * 2);
constexpr size_t WS_DFTC = WS_DFTL + al256((size_t)4096 * 8192 * 2);
constexpr size_t WS_DFT256 = WS_DFTC + al256((size_t)1024 * 512 * 2);
constexpr size_t WS_F1MAT = WS_DFT256 + al256((size_t)256 * 512 * 2);
constexpr size_t WS_F2MAT = WS_F1MAT + al256((size_t)512 * 512 * 2);
constexpr size_t WS_BT2 = WS_F2MAT + al256((size_t)256 * 512 * 2);
constexpr size_t WS_BT2C = WS_BT2 + al256((size_t)2 * 2048 * 8192 * 2);
constexpr int NCC = 34, TOKS = NCC * 128, KRP = 1024 + 64, VTP = TOKS + 64;
constexpr size_t WS_XST = WS_BT2C + al256((size_t)2 * 2048 * 512 * 2);
constexpr size_t WS_BMT = WS_XST + al256((size_t)2 * 1024 * TOKS * 2);
constexpr size_t WS_SST = WS_BMT + al256((size_t)2 * 256 * TOKS * 2);
constexpr size_t WS_DEC = WS_SST + al256((size_t)2 * NCC * 2 * 16 * 8192 * 4);
constexpr size_t WS_VT = WS_DEC + al256((size_t)2 * NCC * 32 * 4);
constexpr size_t WS_PART = WS_VT + al256((size_t)2 * 8 * 128 * (TOKS + 64) * 2);
constexpr size_t WS_END = WS_PART + al256((size_t)11 * MC * D * 4);
constexpr size_t WS_TW = WS_SST;
constexpr size_t WS_HIN = WS_YB;
constexpr int CW_BAR = 4096, CW_PCNT = 8192, CW_PTMO = 8000;

constexpr int RING_BYTES = 131072, MISC_OFF = RING_BYTES + 320, LDS_BYTES = 147456;

#define XB_TMO      128
#define XB_XCNT(j)  (256  + 64 * (j))
#define XB_XSUB(j)  (1280 + 64 * (j))
#define XB_XGEN(j)  (2304 + 64 * (j))
#define XB_TOP      3328
#define XB_TOPGEN   3392
#define XCD_BAR_WORDS 3456
#define XB_SPIN_CAP (1u << 18)
__device__ __forceinline__ unsigned xb_ld(unsigned* p)              { return __hip_atomic_load(p, __ATOMIC_RELAXED, __HIP_MEMORY_SCOPE_AGENT); }
__device__ __forceinline__ unsigned xb_add(unsigned* p, unsigned v) { return __hip_atomic_fetch_add(p, v, __ATOMIC_RELAXED, __HIP_MEMORY_SCOPE_AGENT); }
__device__ __forceinline__ unsigned xb_xcc_id() { return (unsigned)__builtin_amdgcn_s_getreg((3 << 11) | 20) & 0xFu; }
#define XB_SPIN(cond, bar) do { unsigned _sp = 0; while (cond) { __builtin_amdgcn_s_sleep(1); \
    if ((++_sp & 255u) == 0u) { if (xb_ld(&(bar)[XB_TMO])) break; if (_sp > XB_SPIN_CAP) { atomicAdd(&(bar)[XB_TMO], 1u); break; } } } } while (0)
struct XcdBarrier { unsigned* bar; unsigned x; volatile LAS unsigned* st; };
__device__ __forceinline__ XcdBarrier xcd_barrier_post(unsigned* bar, volatile LAS unsigned* st) {
    XcdBarrier b; b.bar = bar; b.x = xb_xcc_id(); b.st = st;
    if (threadIdx.x == 0) (void)xb_add(&bar[XB_XCNT(b.x)], 1u);
    return b;
}
__device__ __forceinline__ void xcd_barrier_complete(unsigned* bar, unsigned x, unsigned& nloc, unsigned& nx) {
    const unsigned G = gridDim.x * gridDim.y * gridDim.z;
    unsigned sum, cnt, mine, sp = 0u;
    for (;;) {
        sum = 0u; cnt = 0u; mine = 0u;
#pragma unroll
        for (unsigned j = 0; j < 16; ++j) { const unsigned c = xb_ld(&bar[XB_XCNT(j)]); sum += c; cnt += (c > 0u) ? 1u : 0u; mine = (j == x) ? c : mine; }
        if (sum == G) break;
        __builtin_amdgcn_s_sleep(1);
        if ((++sp & 255u) == 0u) { if (xb_ld(&bar[XB_TMO])) break; if (sp > XB_SPIN_CAP) { atomicAdd(&bar[XB_TMO], 1u); break; } }
    }
    nloc = mine > 0u ? mine : 1u; nx = cnt > 0u ? cnt : 1u;
}
__device__ __forceinline__ void xcd_barrier(const XcdBarrier& b) {
    asm volatile("s_waitcnt vmcnt(0)" ::: "memory");
    __syncthreads();
    if (threadIdx.x == 0) {
        unsigned* bar = b.bar;
        __builtin_amdgcn_s_waitcnt(0);
        unsigned nloc = b.st[0], nx = b.st[1];
        if (nloc == 0u) { xcd_barrier_complete(bar, b.x, nloc, nx); b.st[0] = nloc; b.st[1] = nx; }
        const unsigned old = xb_add(&bar[XB_XSUB(b.x)], 1u);
        const unsigned gen = old / nloc;
        if (old + 1u == (gen + 1u) * nloc) {
            __builtin_amdgcn_fence(__ATOMIC_RELEASE, "agent");
            asm volatile("s_waitcnt vmcnt(0)" ::: "memory");
            const unsigned og = xb_add(&bar[XB_TOP], 1u);
            const unsigned tg = og / nx;
            if (og + 1u == (tg + 1u) * nx) xb_add(&bar[XB_TOPGEN], 1u);
            else XB_SPIN(xb_ld(&bar[XB_TOPGEN]) == tg, bar);
            __builtin_amdgcn_fence(__ATOMIC_ACQUIRE, "agent");
            xb_add(&bar[XB_XGEN(b.x)], 1u);
            asm volatile("s_waitcnt vmcnt(0)" ::: "memory");
        } else {
            XB_SPIN(xb_ld(&bar[XB_XGEN(b.x)]) == gen, bar);
            __builtin_amdgcn_fence(__ATOMIC_ACQUIRE, "agent");
            asm volatile("s_waitcnt vmcnt(0)" ::: "memory");
        }
    }
    __syncthreads();
}

__device__ __forceinline__ float shx(float v, int o, int lane) { return __int_as_float(__builtin_amdgcn_ds_bpermute((lane ^ o) << 2, __float_as_int(v))); }
__device__ __forceinline__ float wave_sum(float v, int lane) {
#pragma unroll
    for (int o = 1; o < 64; o <<= 1) v += shx(v, o, lane);
    return v;
}
__device__ __forceinline__ float wave_max(float v, int lane) {
#pragma unroll
    for (int o = 1; o < 64; o <<= 1) v = fmaxf(v, shx(v, o, lane));
    return v;
}
__device__ __forceinline__ float bf2f(unsigned short b) { return __uint_as_float(((unsigned)b) << 16); }
__device__ __forceinline__ float bflo(unsigned w) { return __uint_as_float(w << 16); }
__device__ __forceinline__ float bfhi(unsigned w) { return __uint_as_float(w & 0xffff0000u); }
__device__ __forceinline__ unsigned short f2bf(float f) { return (unsigned short)(cvt_pk_bf16(f, 0.f) & 0xffffu); }
__device__ __forceinline__ float fast_silu(float x) { return x * __builtin_amdgcn_rcpf(1.0f + __builtin_amdgcn_exp2f(-x * LOG2E)); }
__device__ __forceinline__ float silu_acc(float x) { return x / (1.f + expf(-x)); }
__device__ __forceinline__ int panel_v(int P) { return P < 32 ? (P >> 4) : 2; }
__device__ __forceinline__ int row_v(int row) { return row < ML ? (row >> 12) : 2; }

struct EpiSwiglu {
    static constexpr bool PERM = true;
    bf16_t* H;
    __device__ __forceinline__ void operator()(const f32x4 (&acc)[2][2][4][2], const pg8::Unit& u, int wr, int wc, int fr, int fq) const {
        const int row0 = u.pm * 256 + wr * 64 + fr, col0 = u.pn * 128 + wc * 32 + 8 * fq;
#pragma unroll
        for (int ai = 0; ai < 2; ++ai)
#pragma unroll
            for (int m = 0; m < 4; ++m) {
                bf16_t* rowp = H + (size_t)(row0 + ai * 128 + m * 16) * HP + col0;
                const f32x4 a0 = acc[ai][0][m][0], a1 = acc[ai][0][m][1], b0 = acc[ai][1][m][0], b1 = acc[ai][1][m][1];
                u32x4 w;
                w.x = cvt_pk_bf16(fast_silu(a0[0]) * b0[0], fast_silu(a0[1]) * b0[1]); w.y = cvt_pk_bf16(fast_silu(a0[2]) * b0[2], fast_silu(a0[3]) * b0[3]);
                w.z = cvt_pk_bf16(fast_silu(a1[0]) * b1[0], fast_silu(a1[1]) * b1[1]); w.w = cvt_pk_bf16(fast_silu(a1[2]) * b1[2], fast_silu(a1[3]) * b1[3]);
                *(u32x4*)rowp = w;
            }
    }
};
struct EpiNull { static constexpr bool PERM = true; __device__ __forceinline__ void operator()(const f32x4 (&acc)[2][2][4][2], const pg8::Unit& u, int wr, int wc, int fr, int fq) const {
    f32x4 t = {0.f, 0.f, 0.f, 0.f};
#pragma unroll
    for (int a = 0; a < 2; ++a)
#pragma unroll
        for (int b = 0; b < 2; ++b)
#pragma unroll
            for (int m = 0; m < 4; ++m)
#pragma unroll
                for (int n = 0; n < 2; ++n) t += acc[a][b][m][n];
    if (t[0] + t[1] + t[2] + t[3] == 1.2345e-33f) __builtin_amdgcn_s_sleep(1); } };
template <bool ATOMIC> struct EpiResid {
    static constexpr bool PERM = false;
    const float* xin; float* xout; const float* gate; float gs; int pm_off; int wt;
    __device__ __forceinline__ void operator()(const f32x4 (&acc)[2][2][4][2], const pg8::Unit& u, int wr, int wc, int fr, int fq) const {
        const int row0 = u.pm * 256 + wr * 64 + fr, col0 = u.pn * 256 + wc * 32 + 4 * fq;
        const float* gp = gate + (size_t)panel_v(u.pm + pm_off) * NMOD + col0;
        f32x4 gv[2][2];
#pragma unroll
        for (int bj = 0; bj < 2; ++bj)
#pragma unroll
            for (int n = 0; n < 2; ++n) gv[bj][n] = *(const f32x4*)(gp + bj * 128 + n * 16);
        asm volatile("" : "+v"(gv[0][0]), "+v"(gv[0][1]), "+v"(gv[1][0]), "+v"(gv[1][1]));
#pragma unroll
        for (int bj = 0; bj < 2; ++bj)
#pragma unroll
            for (int n = 0; n < 2; ++n) gv[bj][n] = gv[bj][n] * gs;
#pragma unroll
        for (int ai = 0; ai < 2; ++ai) {
            f32x4 xi[4][2][2];
            if (!ATOMIC) {
#pragma unroll
                for (int m = 0; m < 4; ++m)
#pragma unroll
                    for (int bj = 0; bj < 2; ++bj)
#pragma unroll
                        for (int n = 0; n < 2; ++n) xi[m][bj][n] = *(const f32x4*)(xin + (size_t)(row0 + ai * 128 + m * 16) * D + col0 + bj * 128 + n * 16);
                asm volatile("" ::: "memory");
            }
#pragma unroll
            for (int m = 0; m < 4; ++m) {
                const size_t off = (size_t)(row0 + ai * 128 + m * 16) * D + col0;
#pragma unroll
                for (int bj = 0; bj < 2; ++bj)
#pragma unroll
                    for (int n = 0; n < 2; ++n) {
                        const f32x4 v = gv[bj][n] * acc[ai][bj][m][n];
                        if (!ATOMIC) *(f32x4*)(xout + off + bj * 128 + n * 16) = xi[m][bj][n] + v;
                        else { float* p = xout + off + bj * 128 + n * 16; unsafeAtomicAdd(p, v[0]); unsafeAtomicAdd(p + 1, v[1]); unsafeAtomicAdd(p + 2, v[2]); unsafeAtomicAdd(p + 3, v[3]); }
                    }
            }
            if (!ATOMIC) asm volatile("" ::: "memory");
        }
    }
};
struct EpiPart {
    static constexpr bool PERM = false;
    float* part; const float* gate; float gs;
    __device__ __forceinline__ void operator()(const f32x4 (&acc)[2][2][4][2], const pg8::Unit& u, int wr, int wc, int fr, int fq) const {
        const int row0 = u.pm * 256 + wr * 64 + fr, col0 = u.pn * 256 + wc * 32 + 4 * fq;
        const float* gp = gate + (size_t)2 * NMOD + col0; float* pb = part + (size_t)u.pz * MC * D;
        f32x4 gv[2][2];
#pragma unroll
        for (int bj = 0; bj < 2; ++bj)
#pragma unroll
            for (int n = 0; n < 2; ++n) gv[bj][n] = *(const f32x4*)(gp + bj * 128 + n * 16) * gs;
#pragma unroll
        for (int ai = 0; ai < 2; ++ai)
#pragma unroll
            for (int m = 0; m < 4; ++m) {
                const size_t off = (size_t)(row0 + ai * 128 + m * 16) * D + col0;
#pragma unroll
                for (int bj = 0; bj < 2; ++bj)
#pragma unroll
                    for (int n = 0; n < 2; ++n) *(f32x4*)(pb + off + bj * 128 + n * 16) = gv[bj][n] * acc[ai][bj][m][n];
            }
    }
};
struct EpiStoreBf16 {
    static constexpr bool PERM = true;
    bf16_t* O; int ldo; float scale; long zstride;
    __device__ __forceinline__ void operator()(const f32x4 (&acc)[2][2][4][2], const pg8::Unit& u, int wr, int wc, int fr, int fq) const {
        const int row0 = u.pm * 256 + wr * 64 + fr, col0 = u.pn * 256 + wc * 32 + 8 * fq;
        bf16_t* base = O + (size_t)u.pz * zstride;
#pragma unroll
        for (int ai = 0; ai < 2; ++ai)
#pragma unroll
            for (int m = 0; m < 4; ++m) {
                bf16_t* rowp = base + (size_t)(row0 + ai * 128 + m * 16) * ldo + col0;
#pragma unroll
                for (int bj = 0; bj < 2; ++bj) { const f32x4 v0 = acc[ai][bj][m][0] * scale, v1 = acc[ai][bj][m][1] * scale;
                    u32x4 w; w.x = cvt_pk_bf16(v0[0], v0[1]); w.y = cvt_pk_bf16(v0[2], v0[3]); w.z = cvt_pk_bf16(v1[0], v1[1]); w.w = cvt_pk_bf16(v1[2], v1[3]);
                    *(u32x4*)(rowp + bj * 128) = w; }
            }
    }
};
struct EpiF1 {
    static constexpr bool PERM = true;
    bf16_t* BT2; int L;
    __device__ __forceinline__ void operator()(const f32x4 (&acc)[2][2][4][2], const pg8::Unit& u, int wr, int wc, int fr, int fq) const {
        const int b = u.pz >> 2, g = u.pz & 3;
        const int row0 = g * 512 + (u.pm & 1) * 256 + wr * 64 + fr, col0 = (u.pm >> 1) * L + u.pn * 256 + wc * 32 + 8 * fq;
        bf16_t* base = BT2 + (size_t)b * 2048 * 2 * L;
#pragma unroll
        for (int ai = 0; ai < 2; ++ai)
#pragma unroll
            for (int m = 0; m < 4; ++m) {
                bf16_t* rowp = base + (size_t)(row0 + ai * 128 + m * 16) * (2 * L) + col0;
#pragma unroll
                for (int bj = 0; bj < 2; ++bj) { const f32x4 v0 = acc[ai][bj][m][0], v1 = acc[ai][bj][m][1];
                    u32x4 w; w.x = cvt_pk_bf16(v0[0], v0[1]); w.y = cvt_pk_bf16(v0[2], v0[3]); w.z = cvt_pk_bf16(v1[0], v1[1]); w.w = cvt_pk_bf16(v1[2], v1[3]);
                    *(u32x4*)(rowp + bj * 128) = w; }
            }
    }
};

struct EpiF1b {
    static constexpr bool PERM = true;
    bf16_t* BT2;
    __device__ __forceinline__ void operator()(const f32x4 (&acc)[2][2][4][2], const pg8::Unit& u, int wr, int wc, int fr, int fq) const {
        const int bt = u.pz >> 2, g = u.pz & 3, ri = u.pm >> 1;
        const int ch0 = g * 512 + (u.pm & 1) * 256 + wr * 64 + fr, a0 = wc * 32 + 8 * fq;
#pragma unroll
        for (int ai = 0; ai < 2; ++ai)
#pragma unroll
            for (int m = 0; m < 4; ++m) {
                bf16_t* rowp = BT2 + ((((size_t)bt * 2048 + ch0 + ai * 128 + m * 16) * 16 + u.pn) * 2 + ri) * 256 + a0;
#pragma unroll
                for (int bj = 0; bj < 2; ++bj) { const f32x4 v0 = acc[ai][bj][m][0], v1 = acc[ai][bj][m][1];
                    u32x4 w; w.x = cvt_pk_bf16(v0[0], v0[1]); w.y = cvt_pk_bf16(v0[2], v0[3]); w.z = cvt_pk_bf16(v1[0], v1[1]); w.w = cvt_pk_bf16(v1[2], v1[3]);
                    *(u32x4*)(rowp + bj * 128) = w; }
            }
    }
};
struct EpiTw {
    static constexpr bool PERM = true;
    bf16_t* TW;
    __device__ __forceinline__ void operator()(const f32x4 (&acc)[2][2][4][2], const pg8::Unit& u, int wr, int wc, int fr, int fq) const {
        const int b0 = 8 * (fq & 1);
#pragma unroll
        for (int m = 0; m < 4; ++m) {
            const int k1 = u.pm * 128 + wr * 64 + m * 16 + fr;
            float cs[8], sn[8];
#pragma unroll
            for (int e = 0; e < 8; ++e) { const float ph = (float)(((b0 + e) * k1) & 4095) * (1.f / 4096.f); cs[e] = __builtin_amdgcn_cosf(ph); sn[e] = __builtin_amdgcn_sinf(ph); }
#pragma unroll
            for (int bj = 0; bj < 2; ++bj) {
                const int ch = u.pn * 16 + bj * 8 + wc * 2 + (fq >> 1);
                const f32x4 r0 = acc[0][bj][m][0], r1 = acc[0][bj][m][1], i0 = acc[1][bj][m][0], i1 = acc[1][bj][m][1];
                const float tr[8] = {r0[0], r0[1], r0[2], r0[3], r1[0], r1[1], r1[2], r1[3]}, ti[8] = {i0[0], i0[1], i0[2], i0[3], i1[0], i1[1], i1[2], i1[3]};
                float orr[8], oi[8];
#pragma unroll
                for (int e = 0; e < 8; ++e) { orr[e] = tr[e] * cs[e] + ti[e] * sn[e]; oi[e] = ti[e] * cs[e] - tr[e] * sn[e]; }
                bf16_t* dst = TW + ((((size_t)u.pz * 2048 + ch) * 256 + k1) * 2) * 16 + b0;
                *(u32x4*)dst = (u32x4){cvt_pk_bf16(orr[0], orr[1]), cvt_pk_bf16(orr[2], orr[3]), cvt_pk_bf16(orr[4], orr[5]), cvt_pk_bf16(orr[6], orr[7])};
                *(u32x4*)(dst + 16) = (u32x4){cvt_pk_bf16(oi[0], oi[1]), cvt_pk_bf16(oi[2], oi[3]), cvt_pk_bf16(oi[4], oi[5]), cvt_pk_bf16(oi[6], oi[7])};
            }
        }
    }
};
struct EpiFS2 {
    static constexpr bool PERM = true;
    bf16_t* O; float scale;
    __device__ __forceinline__ void operator()(const f32x4 (&acc)[2][2][4][2], const pg8::Unit& u, int wr, int wc, int fr, int fq) const {
        const int bt = u.pz >> 4, k1g = u.pz & 15, col0 = u.pn * 256 + wc * 32 + 8 * fq;
#pragma unroll
        for (int ai = 0; ai < 2; ++ai)
#pragma unroll
            for (int m = 0; m < 4; ++m) {
                const int R = ai * 128 + wr * 64 + m * 16 + fr, k = 16 * k1g + (R >> 4) + 256 * (R & 15);
                bf16_t* rowp = O + ((size_t)bt * 4096 + k) * D + col0;
#pragma unroll
                for (int bj = 0; bj < 2; ++bj) { const f32x4 v0 = acc[ai][bj][m][0] * scale, v1 = acc[ai][bj][m][1] * scale;
                    u32x4 w; w.x = cvt_pk_bf16(v0[0], v0[1]); w.y = cvt_pk_bf16(v0[2], v0[3]); w.z = cvt_pk_bf16(v1[0], v1[1]); w.w = cvt_pk_bf16(v1[2], v1[3]);
                    *(u32x4*)(rowp + bj * 128) = w; }
            }
    }
};

struct Args { const float* in[21]; float* out; unsigned char* ws; int ph_lo, ph_hi; };
struct Frame { LAS unsigned char* lds; };
typedef const __attribute__((address_space(4))) Args* KArgsPtr;
__device__ __forceinline__ KArgsPtr ka_ptr() { KArgsPtr p = (KArgsPtr)__builtin_amdgcn_kernarg_segment_ptr(); asm volatile("" : "+s"(p)); return p; }
#define KA_LOAD() const KArgsPtr KA = ka_ptr()
#define WSP(T, off) ((T*)(KA->ws + (off)))
#define PHASE_IDS() KA_LOAD(); int tz_ = threadIdx.x; asm volatile("" : "+v"(tz_)); const int tid = tz_, lane = tz_ & 63, wave = __builtin_amdgcn_readfirstlane(tz_ >> 6); const int G_ = (int)gridDim.x, vcu_ = (G_ % 8 == 0) ? ((int)blockIdx.x % 8) * (G_ / 8) + (int)blockIdx.x / 8 : (int)blockIdx.x; const int gw = vcu_ * NWAVES + wave, NGW = G_ * NWAVES; (void)tid; (void)lane; (void)gw; (void)NGW

__device__ __forceinline__ void transpose_item(const float* W, int N, int k0, int n0, bf16_t* WT, int ldt, int drow0, LAS float* scr, int lane) {
#pragma unroll 8
    for (int i = 0; i < 32; ++i) { const int kk = 2 * i + (lane >> 5); scr[kk * 33 + (lane & 31)] = MK_NT_PRO ? __builtin_nontemporal_load(W + (size_t)(k0 + kk) * N + n0 + (lane & 31)) : W[(size_t)(k0 + kk) * N + n0 + (lane & 31)]; }
    asm volatile("s_waitcnt lgkmcnt(0)" ::: "memory");
    const int c = lane & 7;
#pragma unroll
    for (int j = 0; j < 4; ++j) { const int n = (lane >> 3) + 8 * j; const LAS float* s = scr + (8 * c) * 33 + n;
        u32x4 o; o.x = cvt_pk_bf16(s[0 * 33], s[1 * 33]); o.y = cvt_pk_bf16(s[2 * 33], s[3 * 33]); o.z = cvt_pk_bf16(s[4 * 33], s[5 * 33]); o.w = cvt_pk_bf16(s[6 * 33], s[7 * 33]);
        if (MK_NT_PRO) __builtin_nontemporal_store(o, (u32x4*)(WT + (size_t)(drow0 + n) * ldt + k0 + 8 * c)); else *(u32x4*)(WT + (size_t)(drow0 + n) * ldt + k0 + 8 * c) = o; }
    asm volatile("s_waitcnt lgkmcnt(0)" ::: "memory");
}
__device__ __forceinline__ void ph_weights(Frame& F) {
    PHASE_IDS();
    LAS float* scr = (LAS float*)(F.lds + wave * 16384);
    constexpr int I_FFN = 32 * 176, I_IN = 32 * 177, I_SQ = 32 * 64;
    constexpr int NITEMS = 24 * I_FFN + 2 * I_IN + 4 * I_SQ;
    for (int it = gw; it < NITEMS; it += NGW) {
        int r = it;
        if (r < 24 * I_FFN) {
            const int mat = r / I_FFN, item = r % I_FFN, ls = mat / 3, which = mat % 3;
            if (which < 2) {
                const int kb = item / 176, nb = item % 176, n0 = nb * 32;
                transpose_item((which ? KA->in[8] : KA->in[7]) + (size_t)ls * D * DFF, DFF, kb * 64, n0, WSP(bf16_t, WS_W13) + (size_t)ls * 2 * DFF * D, D, 256 * (n0 >> 7) + (n0 & 127) + which * 128, scr, lane);
            } else {
                const int kb = item / 64, nb = item % 64, n0 = nb * 32;
                transpose_item(KA->in[9] + (size_t)ls * DFF * D, D, kb * 64, n0, WSP(bf16_t, WS_W2) + (size_t)ls * D * HP, HP, n0, scr, lane);
            }
            continue;
        }
        r -= 24 * I_FFN;
        if (r < 2 * I_IN) {
            const int j = r / I_IN, item = r % I_IN, kb = item / 177, nb = item % 177, n0 = nb * 32;
            if (n0 < NPJ) transpose_item(KA->in[10] + (size_t)j * D * INW, INW, kb * 64, n0, WSP(bf16_t, WS_WIN) + (size_t)j * NPJ * D, D, n0, scr, lane);
            else transpose_item(KA->in[10] + (size_t)j * D * INW, INW, kb * 64, n0, WSP(bf16_t, WS_WDT) + (size_t)j * 32 * D, D, 0, scr, lane);
            continue;
        }
        r -= 2 * I_IN;
        { const int mat = r / I_SQ, item = r % I_SQ, kb = item / 64, nb = item % 64, n0 = nb * 32, j = mat & 1;
          const float* src = (mat < 2 ? KA->in[11] : KA->in[20]) + (size_t)j * D * D;
          bf16_t* dst = (mat < 2 ? WSP(bf16_t, WS_WOUT) : WSP(bf16_t, WS_WF)) + (size_t)j * D * D;
          transpose_item(src, D, kb * 64, n0, dst, D, n0, scr, lane); }
    }
}
__device__ __forceinline__ void ph_mod(Frame& F) {
    PHASE_IDS();
    LAS float* sv = (LAS float*)F.lds;
    LAS float* red = (LAS float*)(F.lds + 24576);
    for (int i = tid; i < 3 * D; i += NTHR) { const int v = i / D, k = i % D; const float x = v < 2 ? KA->in[1][v * D + k] : KA->in[3][k]; sv[i] = silu_acc(x); }
    __syncthreads();
    const int cq = tid % 24, ks = tid / 24;
    for (int it = vcu_; it < 4 * 192; it += G_) {
        const int l = it / 192, cb = it % 192;
        if (ks < 21) {
            const float* w = KA->in[4] + (size_t)l * D * NMOD + cb * 96 + cq * 4;
            const int kbeg = ks * 98, kend = kbeg + 98 < D ? kbeg + 98 : D;
            f32x4 a0 = {0.f, 0.f, 0.f, 0.f}, a1 = a0, a2 = a0;
#pragma unroll 14
            for (int k = kbeg; k < kend; ++k) { const f32x4 wv = MK_NT_PRO ? __builtin_nontemporal_load((const f32x4*)(w + (size_t)k * NMOD)) : *(const f32x4*)(w + (size_t)k * NMOD); a0 += wv * sv[k]; a1 += wv * sv[D + k]; a2 += wv * sv[2 * D + k]; }
            *(LAS f32x4*)(red + (ks * 3 + 0) * 96 + cq * 4) = a0; *(LAS f32x4*)(red + (ks * 3 + 1) * 96 + cq * 4) = a1; *(LAS f32x4*)(red + (ks * 3 + 2) * 96 + cq * 4) = a2;
        }
        __syncthreads();
        if (tid < 288) { const int v = tid / 96, c = tid % 96; float s = 0.f;
#pragma unroll
            for (int q = 0; q < 21; ++q) s += red[(q * 3 + v) * 96 + c];
            const int j = cb * 96 + c; WSP(float, WS_MOD)[(size_t)(l * 3 + v) * NMOD + j] = s + KA->in[5][l * NMOD + j]; }
        __syncthreads();
    }
}
__device__ __forceinline__ void ph_tables(Frame& F) {
    PHASE_IDS();
    const size_t gt = (size_t)vcu_ * NTHR + tid, NT = (size_t)G_ * NTHR;
    for (size_t it = gt; it < (size_t)1024 * 64; it += NT) { const int mp = (int)(it >> 6), c0 = (int)(it & 63) * 8, m = mp & 511; unsigned o[4];
#pragma unroll
        for (int e = 0; e < 4; ++e) { const float x0 = (float)((m * (c0 + 2 * e)) & 511) * (1.f / 512.f), x1 = (float)((m * (c0 + 2 * e + 1)) & 511) * (1.f / 512.f);
            o[e] = mp < 512 ? cvt_pk_bf16(__builtin_amdgcn_cosf(x0), __builtin_amdgcn_cosf(x1)) : cvt_pk_bf16(__builtin_amdgcn_sinf(x0), __builtin_amdgcn_sinf(x1)); }
        *(u32x4*)(WSP(bf16_t, WS_DFTC) + (size_t)mp * 512 + c0) = (u32x4){o[0], o[1], o[2], o[3]}; }
    for (size_t it = gt; it < (size_t)256 * 32; it += NT) { const int k = (int)(it >> 5), l0 = (int)(it & 31) * 8; unsigned c[4], s[4];
#pragma unroll
        for (int e = 0; e < 4; ++e) { const float x0 = (float)((k * (l0 + 2 * e)) & 255) * (1.f / 256.f), x1 = (float)((k * (l0 + 2 * e + 1)) & 255) * (1.f / 256.f);
            c[e] = cvt_pk_bf16(__builtin_amdgcn_cosf(x0), __builtin_amdgcn_cosf(x1)); s[e] = cvt_pk_bf16(-__builtin_amdgcn_sinf(x0), -__builtin_amdgcn_sinf(x1)); }
        bf16_t* rowp = WSP(bf16_t, WS_DFT256) + (size_t)k * 512 + l0; *(u32x4*)rowp = (u32x4){c[0], c[1], c[2], c[3]}; *(u32x4*)(rowp + 256) = (u32x4){s[0], s[1], s[2], s[3]}; }
    for (size_t it = gt; it < (size_t)512 * 64; it += NT) { const int R = (int)(it >> 6), c0 = (int)(it & 63) * 8, k1 = (R >> 8) * 128 + (R & 127), rip = (R >> 7) & 1, ri = c0 >> 8; unsigned o[4];
#pragma unroll
        for (int e = 0; e < 4; ++e) { float v[2];
#pragma unroll
            for (int hh = 0; hh < 2; ++hh) { const int a = (c0 + 2 * e + hh) & 255; const float x = (float)((a * k1) & 255) * (1.f / 256.f), c = __builtin_amdgcn_cosf(x), sn = __builtin_amdgcn_sinf(x);
                v[hh] = rip == 0 ? (ri == 0 ? c : -sn) : (ri == 0 ? -sn : -c); }
            o[e] = cvt_pk_bf16(v[0], v[1]); }
        *(u32x4*)(WSP(bf16_t, WS_F1MAT) + (size_t)R * 512 + c0) = (u32x4){o[0], o[1], o[2], o[3]}; }
    for (size_t it = gt; it < (size_t)256 * 64; it += NT) { const int R = (int)(it >> 6), c0 = (int)(it & 63) * 8, k1lp = R >> 4, k2 = R & 15, k1l = c0 >> 5, ri = (c0 >> 4) & 1; unsigned o[4];
#pragma unroll
        for (int e = 0; e < 4; ++e) { float v[2];
#pragma unroll
            for (int hh = 0; hh < 2; ++hh) { const int b = (c0 + 2 * e + hh) & 15; const float x = (float)((b * k2) & 15) * (1.f / 16.f);
                v[hh] = k1l == k1lp ? (ri == 0 ? __builtin_amdgcn_cosf(x) : __builtin_amdgcn_sinf(x)) : 0.f; }
            o[e] = cvt_pk_bf16(v[0], v[1]); }
        *(u32x4*)(WSP(bf16_t, WS_F2MAT) + (size_t)R * 512 + c0) = (u32x4){o[0], o[1], o[2], o[3]}; }
    for (size_t it = gt; it < 64 * 32; it += NT) { const int pos = (int)(it >> 5), j = (int)(it & 31); const float a = (float)pos * powf(10000.f, -(float)j / 32.f); WSP(f32x2, WS_ROPE)[it] = (f32x2){cosf(a), sinf(a)}; }
}

__device__ __forceinline__ void ph_norm(Frame& F, const float* g, const float* modl, int s, int row_lo, int nrows, int npart, const float* xlat, const float* xctx) {
    PHASE_IDS();
    float* XR = WSP(float, WS_XR); bf16_t* XN = WSP(bf16_t, WS_XN); const float* PART = WSP(float, WS_PART);
    const int nmain = (npart > 0 && nrows > ML) ? ML : nrows;
    f32x4 v[8], nx[8];
    const int rfirst = row_lo + gw;
    if (rfirst < nmain) { const f32x4* xi = (const f32x4*)(rfirst < ML ? xlat + (size_t)rfirst * D : xctx + (size_t)(rfirst - ML) * D) + lane;
#pragma unroll
        for (int j = 0; j < 8; ++j) v[j] = MK_NT_X ? __builtin_nontemporal_load(xi + 64 * j) : xi[64 * j]; }
    for (int row = rfirst; row < nmain; row += NGW) {
        const int nrow = row + NGW;
        if (nrow < nmain) { const f32x4* xi = (const f32x4*)(nrow < ML ? xlat + (size_t)nrow * D : xctx + (size_t)(nrow - ML) * D) + lane;
#pragma unroll
            for (int j = 0; j < 8; ++j) nx[j] = MK_NT_X ? __builtin_nontemporal_load(xi + 64 * j) : xi[64 * j]; }
        const float* md = modl + (size_t)row_v(row) * NMOD;
        f32x4 gg[8], sc[8], sh[8];
#pragma unroll
        for (int j = 0; j < 8; ++j) { const int c = 4 * lane + 256 * j; gg[j] = *(const f32x4*)(g + c); sc[j] = *(const f32x4*)(md + (s + 1) * D + c); sh[j] = *(const f32x4*)(md + s * D + c); }
        float ss = 0.f;
#pragma unroll
        for (int j = 0; j < 8; ++j) ss += (v[j].x * v[j].x + v[j].y * v[j].y) + (v[j].z * v[j].z + v[j].w * v[j].w);
        const float r = 1.0f / sqrtf(wave_sum(ss, lane) * (1.f / D) + EPS);
        u32x2* o8 = (u32x2*)(XN + (size_t)row * D) + lane;
#pragma unroll
        for (int j = 0; j < 8; ++j) { const f32x4 y = v[j] * r * gg[j] * (sc[j] + 1.0f) + sh[j]; o8[64 * j] = (u32x2){cvt_pk_bf16(y.x, y.y), cvt_pk_bf16(y.z, y.w)}; }
#pragma unroll
        for (int j = 0; j < 8; ++j) v[j] = nx[j];
    }
    if (nmain < nrows) {
        const float* md = modl + (size_t)2 * NMOD;
        LAS float* red = (LAS float*)F.lds;
        const int cbase = (wave & 3) * 512 + 4 * lane;
        for (int rb = vcu_ * 2; rb < nrows - ML; rb += G_ * 2) {
            const int row = ML + rb + (wave >> 2);
            const float* xi = xctx + (size_t)(row - ML) * D + cbase; float* xr = XR + (size_t)row * D + cbase;
            f32x4 w0 = *(const f32x4*)xi, w1 = *(const f32x4*)(xi + 256);
            for (int sp = 0; sp < npart; sp += 4) {
                f32x4 t[4][2];
#pragma unroll
                for (int q = 0; q < 4; ++q) { const int spq = sp + q < npart ? sp + q : sp; const float* pr = PART + ((size_t)spq * MC + (row - ML)) * D + cbase; t[q][0] = *(const f32x4*)pr; t[q][1] = *(const f32x4*)(pr + 256); }
                asm volatile("" ::: "memory");
#pragma unroll
                for (int q = 0; q < 4; ++q) if (sp + q < npart) { w0 += t[q][0]; w1 += t[q][1]; }
            }
            *(f32x4*)xr = w0; *(f32x4*)(xr + 256) = w1;
            float ss = (w0.x * w0.x + w0.y * w0.y) + (w0.z * w0.z + w0.w * w0.w) + (w1.x * w1.x + w1.y * w1.y) + (w1.z * w1.z + w1.w * w1.w);
            ss = wave_sum(ss, lane);
            if (lane == 0) red[wave] = ss;
            __syncthreads();
            const int w4 = wave & ~3; const float tot = (red[w4] + red[w4 + 1]) + (red[w4 + 2] + red[w4 + 3]);
            const float r = 1.0f / sqrtf(tot * (1.f / D) + EPS);
            bf16_t* xo = XN + (size_t)row * D + cbase;
#pragma unroll
            for (int j = 0; j < 2; ++j) { const int c = cbase + 256 * j; const f32x4 ww = j ? w1 : w0;
                const f32x4 y = ww * r * *(const f32x4*)(g + c) * (*(const f32x4*)(md + (s + 1) * D + c) + 1.0f) + *(const f32x4*)(md + s * D + c);
                *(u32x2*)(xo + 256 * j) = (u32x2){cvt_pk_bf16(y.x, y.y), cvt_pk_bf16(y.z, y.w)}; }
            __syncthreads();
        }
    }
}
__device__ __forceinline__ void panel_publish(KArgsPtr KA, int site) {
    pg8::Order S; S.init(ML, D, 1, (int)gridDim.x, (int)blockIdx.x); pg8::Unit u; if (!S.next(0, u)) return;
    if (threadIdx.x == 0) {
        asm volatile("s_waitcnt vmcnt(0)" ::: "memory");
        (void)__hip_atomic_fetch_add(WSP(unsigned, WS_CTL) + CW_PCNT + (site * 32 + u.pm) * 64, 1u, __ATOMIC_RELAXED, __HIP_MEMORY_SCOPE_AGENT);
    }
}
__device__ __forceinline__ void panel_norm(Frame& F, int site, const float* g, const float* modl, int s) {
    PHASE_IDS();
    pg8::Order S; S.init(ML, D, 1, G_, (int)blockIdx.x); pg8::Unit u; if (!S.next(0, u)) return;
    if (tid == 0) {
        unsigned* ctr = WSP(unsigned, WS_CTL) + CW_PCNT + (site * 32 + u.pm) * 64; unsigned* tmo = WSP(unsigned, WS_CTL) + CW_PTMO; unsigned sp = 0;
        while (__hip_atomic_load(ctr, __ATOMIC_RELAXED, __HIP_MEMORY_SCOPE_AGENT) < 8u) { __builtin_amdgcn_s_sleep(1);
            if ((++sp & 255u) == 0u) { if (__hip_atomic_load(tmo, __ATOMIC_RELAXED, __HIP_MEMORY_SCOPE_AGENT)) break; if (sp > (1u << 18)) { atomicAdd(tmo, 1u); break; } } }
        __builtin_amdgcn_fence(__ATOMIC_ACQUIRE, "agent"); asm volatile("s_waitcnt vmcnt(0)" ::: "memory");
    }
    __syncthreads();
    const float* XR = WSP(float, WS_XR); bf16_t* XN = WSP(bf16_t, WS_XN);
    const int rbase = u.pm * 256 + u.pn * 32 + wave * 4;
    const float* md = modl + (size_t)panel_v(u.pm) * NMOD;
    f32x4 gc[8], sh[8];
#pragma unroll
    for (int j = 0; j < 8; ++j) { const int c = 4 * lane + 256 * j; gc[j] = *(const f32x4*)(g + c) * (*(const f32x4*)(md + (s + 1) * D + c) + 1.0f); sh[j] = *(const f32x4*)(md + s * D + c); }
    f32x4 v[4][8];
#pragma unroll
    for (int i = 0; i < 4; ++i) { const f32x4* xi = (const f32x4*)(XR + (size_t)(rbase + i) * D) + lane;
#pragma unroll
        for (int j = 0; j < 8; ++j) v[i][j] = xi[64 * j]; }
#pragma unroll
    for (int i = 0; i < 4; ++i) {
        float ss = 0.f;
#pragma unroll
        for (int j = 0; j < 8; ++j) ss += (v[i][j].x * v[i][j].x + v[i][j].y * v[i][j].y) + (v[i][j].z * v[i][j].z + v[i][j].w * v[i][j].w);
        const float r = 1.0f / sqrtf(wave_sum(ss, lane) * (1.f / D) + EPS);
        u32x2* o8 = (u32x2*)(XN + (size_t)(rbase + i) * D) + lane;
#pragma unroll
        for (int j = 0; j < 8; ++j) { const f32x4 y = v[i][j] * r * gc[j] + sh[j]; o8[64 * j] = (u32x2){cvt_pk_bf16(y.x, y.y), cvt_pk_bf16(y.z, y.w)}; }
    }
}
__device__ __forceinline__ void ph_dt(Frame& F, int j) {
    PHASE_IDS();
    const bf16_t* XN = WSP(bf16_t, WS_XN); const bf16_t* W = WSP(bf16_t, WS_WDT) + (size_t)j * 32 * D;
    const float* dt_bias = KA->in[16] + j * 32; const float* a_log = KA->in[17] + j * 32; float* DT = WSP(float, WS_DT); float* DA = WSP(float, WS_DA);
    LAS float* part = (LAS float*)F.lds;
    const int l15 = lane & 15, q = lane >> 4, slot = wave >> 1, kh = wave & 1;
    for (int jb = vcu_ * 4; jb < MT / 16; jb += G_ * 4) {
        const int r0 = (jb + slot) * 16;
        const bf16_t* ap = XN + (size_t)(r0 + l15) * D + 1024 * kh + 8 * q; const bf16_t* bp0 = W + (size_t)l15 * D + 1024 * kh + 8 * q; const bf16_t* bp1 = bp0 + 16 * D;
        f32x4 acc0 = {0.f, 0.f, 0.f, 0.f}, acc1 = acc0;
#pragma unroll 1
        for (int kb = 0; kb < 4; ++kb) {
            bf16x8 a[8], b0[8], b1[8];
#pragma unroll
            for (int k = 0; k < 8; ++k) { a[k] = *(const bf16x8*)(ap + 256 * kb + 32 * k); b0[k] = *(const bf16x8*)(bp0 + 256 * kb + 32 * k); b1[k] = *(const bf16x8*)(bp1 + 256 * kb + 32 * k); }
#pragma unroll
            for (int k = 0; k < 8; ++k) { acc0 = __builtin_amdgcn_mfma_f32_16x16x32_bf16(a[k], b0[k], acc0, 0, 0, 0); acc1 = __builtin_amdgcn_mfma_f32_16x16x32_bf16(a[k], b1[k], acc1, 0, 0, 0); }
        }
        *(LAS f32x4*)(part + ((wave * 2 + 0) * 64 + lane) * 4) = acc0; *(LAS f32x4*)(part + ((wave * 2 + 1) * 64 + lane) * 4) = acc1;
        __syncthreads();
        {
            const f32x4 mine = kh ? acc1 : acc0, other = *(const LAS f32x4*)(part + (((wave ^ 1) * 2 + kh) * 64 + lane) * 4);
            const f32x4 sacc = mine + other;
            const int i = kh * 16 + l15; const float bias = dt_bias[i], A = -__expf(a_log[i]);
#pragma unroll
            for (int e = 0; e < 4; ++e) { const int row = r0 + 4 * q + e; const float x = sacc[e] + bias; const float dt = fmaxf(x, 0.f) + log1pf(__expf(-fabsf(x)));
                DT[(size_t)row * 32 + i] = dt; DA[(size_t)row * 32 + i] = dt * A; }
        }
        __syncthreads();
    }
}
__device__ __forceinline__ void ph_qknorm(Frame& F, int j) {
    PHASE_IDS();
    const bf16_t* PROJ = WSP(bf16_t, WS_PROJ); const float* qk_g = KA->in[12] + j * 256;
    bf16_t* QP = WSP(bf16_t, WS_QP); bf16_t* QR = WSP(bf16_t, WS_QR); bf16_t* KR = WSP(bf16_t, WS_KR);
    LAS f32x2* ROPE = (LAS f32x2*)(F.lds + 65536);
    { const f32x2* src = WSP(f32x2, WS_ROPE); for (int i = tid; i < 64 * 32; i += NTHR) ROPE[i] = src[i]; }
    __syncthreads();
    const int a = lane & 7, d0 = a * 16;
    float gq[16], gk[16];
#pragma unroll
    for (int e = 0; e < 16; ++e) { gq[e] = qk_g[d0 + e]; gk[e] = qk_g[128 + d0 + e]; }
    int it = gw;
    u32x4 w0 = {0u, 0u, 0u, 0u}, w1 = w0;
    if (it < MT * 2) { const u32x4* src = (const u32x4*)(PROJ + (size_t)(it >> 1) * NPJ + (it & 1) * 1024 + lane * 16); w0 = MK_NT_X ? __builtin_nontemporal_load(src) : src[0]; w1 = MK_NT_X ? __builtin_nontemporal_load(src + 1) : src[1]; }
    for (; it < MT * 2; it += NGW) {
        const int row = it >> 1, which = it & 1;
        const u32x4 c0 = w0, c1 = w1;
        if (it + NGW < MT * 2) { const int nx = it + NGW; const u32x4* src = (const u32x4*)(PROJ + (size_t)(nx >> 1) * NPJ + (nx & 1) * 1024 + lane * 16); w0 = MK_NT_X ? __builtin_nontemporal_load(src) : src[0]; w1 = MK_NT_X ? __builtin_nontemporal_load(src + 1) : src[1]; }
        float x[16]; const unsigned ww[8] = {c0.x, c0.y, c0.z, c0.w, c1.x, c1.y, c1.z, c1.w};
        float ss = 0.f;
#pragma unroll
        for (int e = 0; e < 8; ++e) { x[2 * e] = bflo(ww[e]); x[2 * e + 1] = bfhi(ww[e]); ss += x[2 * e] * x[2 * e] + x[2 * e + 1] * x[2 * e + 1]; }
        ss += shx(ss, 1, lane); ss += shx(ss, 2, lane); ss += shx(ss, 4, lane);
        const float r = 1.0f / sqrtf(ss * (1.f / 128.f) + EPS);
        float y[16], ro[16];
#pragma unroll
        for (int e = 0; e < 16; ++e) y[e] = x[e] * r * (which ? gk[e] : gq[e]);
        const bool lat = row < ML;
        if (lat) {
            const int t = row & 4095, pos = (a < 4) ? (t >> 6) : (t & 63);
            const LAS f32x2* rp = ROPE + pos * 32 + (a & 1) * 16;
#pragma unroll
            for (int e = 0; e < 16; ++e) { const float p = shx(y[e], 2, lane); const f32x2 cs = rp[e]; ro[e] = (a & 2) ? y[e] * cs.x + p * cs.y : y[e] * cs.x - p * cs.y; }
        } else {
#pragma unroll
            for (int e = 0; e < 16; ++e) ro[e] = y[e];
        }
        u32x4 p0, p1, r0, r1;
        p0.x = cvt_pk_bf16(y[0], y[1]); p0.y = cvt_pk_bf16(y[2], y[3]); p0.z = cvt_pk_bf16(y[4], y[5]); p0.w = cvt_pk_bf16(y[6], y[7]);
        p1.x = cvt_pk_bf16(y[8], y[9]); p1.y = cvt_pk_bf16(y[10], y[11]); p1.z = cvt_pk_bf16(y[12], y[13]); p1.w = cvt_pk_bf16(y[14], y[15]);
        r0.x = cvt_pk_bf16(ro[0], ro[1]); r0.y = cvt_pk_bf16(ro[2], ro[3]); r0.z = cvt_pk_bf16(ro[4], ro[5]); r0.w = cvt_pk_bf16(ro[6], ro[7]);
        r1.x = cvt_pk_bf16(ro[8], ro[9]); r1.y = cvt_pk_bf16(ro[10], ro[11]); r1.z = cvt_pk_bf16(ro[12], ro[13]); r1.w = cvt_pk_bf16(ro[14], ro[15]);
        const size_t o = (size_t)row * 1024 + lane * 16, ok = (size_t)row * KRP + lane * 16;
        if (which == 0) { *(u32x4*)(QP + o) = p0; *(u32x4*)(QP + o + 8) = p1; *(u32x4*)(QR + o) = r0; *(u32x4*)(QR + o + 8) = r1; }
        else { *(u32x4*)(KR + ok) = r0; *(u32x4*)(KR + ok + 8) = r1; }
    }
    __syncthreads();
}
__device__ __forceinline__ void ph_conv(Frame& F, int j) {
    PHASE_IDS();
    const bf16_t* PROJ = WSP(bf16_t, WS_PROJ); const float* cw = KA->in[14] + j * 5 * 1536; const float* cb = KA->in[15] + j * 1536; bf16_t* XBC = WSP(bf16_t, WS_XBC);
    const size_t gt = (size_t)vcu_ * NTHR + tid, NT = (size_t)G_ * NTHR;
    for (size_t it = gt; it < (size_t)MT * 192; it += NT) {
        const int row = (int)(it / 192), ch = (int)(it % 192) * 8;
        int t, L, base; if (row < ML) { t = row & 4095; L = 4096; base = row & ~4095; } else { const int rr = row - ML; t = rr & 255; L = 256; base = ML + (rr & ~255); }
        float acc[8];
#pragma unroll
        for (int e = 0; e < 8; ++e) acc[e] = cb[ch + e];
#pragma unroll
        for (int k = 0; k < 5; ++k) { const int tt = t + k - 2; if (tt >= 0 && tt < L) { const u32x4 w = *(const u32x4*)(PROJ + (size_t)(base + tt) * NPJ + 4096 + ch); const float* cwk = cw + k * 1536 + ch;
                acc[0] += cwk[0] * bflo(w.x); acc[1] += cwk[1] * bfhi(w.x); acc[2] += cwk[2] * bflo(w.y); acc[3] += cwk[3] * bfhi(w.y);
                acc[4] += cwk[4] * bflo(w.z); acc[5] += cwk[5] * bfhi(w.z); acc[6] += cwk[6] * bflo(w.w); acc[7] += cwk[7] * bfhi(w.w); } }
        u32x4 o; o.x = cvt_pk_bf16(silu_acc(acc[0]), silu_acc(acc[1])); o.y = cvt_pk_bf16(silu_acc(acc[2]), silu_acc(acc[3])); o.z = cvt_pk_bf16(silu_acc(acc[4]), silu_acc(acc[5])); o.w = cvt_pk_bf16(silu_acc(acc[6]), silu_acc(acc[7]));
        *(u32x4*)(XBC + (size_t)row * 1536 + ch) = o;
    }
}
__device__ __forceinline__ void ph_ssd_seq(Frame& F) {
    PHASE_IDS();
    const bf16_t* XBC = WSP(bf16_t, WS_XBC); const float* DT = WSP(float, WS_DT); const float* DA = WSP(float, WS_DA);
    for (int id = gw; id < 4096; id += NGW) {
        const int p = id & 63, head = (id >> 6) & 15, dir = (id >> 10) & 1, b = id >> 11, g = head >> 3;
        float h0 = 0.f, h1 = 0.f; float* Y = dir ? WSP(float, WS_YB) : WSP(float, WS_YF);
#pragma unroll 4
        for (int step = 0; step < 256 + 4096; ++step) {
            int row; if (step < 256) { const int t = dir ? 255 - step : step; row = ML + b * 256 + t; } else { const int s = step - 256; const int t = dir ? 4095 - s : s; row = b * 4096 + t; }
            const float dt = DT[row * 32 + dir * 16 + head], da = DA[row * 32 + dir * 16 + head];
            const bf16_t* xr = XBC + (size_t)row * 1536;
            const float x = bf2f(xr[head * 64 + p]);
            const float B0 = bf2f(xr[1024 + g * 128 + lane]), B1 = bf2f(xr[1024 + g * 128 + lane + 64]);
            const float C0 = bf2f(xr[1280 + g * 128 + lane]), C1 = bf2f(xr[1280 + g * 128 + lane + 64]);
            const float dec = __expf(da), dx = dt * x;
            h0 = dec * h0 + dx * B0; h1 = dec * h1 + dx * B1;
            const float y = wave_sum(C0 * h0 + C1 * h1, lane);
            if (lane == 0) Y[(size_t)row * 1024 + head * 64 + p] = y;
        }
    }
}

__device__ __forceinline__ void ph_conv2(Frame& F, int j) {
    PHASE_IDS();
    const bf16_t* PROJ = WSP(bf16_t, WS_PROJ); const float* cw = KA->in[14] + j * 5 * 1536; const float* cb = KA->in[15] + j * 1536; bf16_t* XBC = WSP(bf16_t, WS_XBC);
    for (int wit = gw; wit < (MT / 64) * 24; wit += NGW) {
        const int rg = (wit / 24) * 8 + (lane & 7), ch = (wit % 24) * 64 + (lane >> 3) * 8, row0 = rg * 8;
        int b, t0, L, base, tok0; if (row0 < ML) { b = row0 >> 12; t0 = row0 & 4095; L = 4096; base = b * 4096; tok0 = 256 + t0; } else { const int rr = row0 - ML; b = rr >> 8; t0 = rr & 255; L = 256; base = ML + b * 256; tok0 = t0; }
        u32x4 xin[12];
#pragma unroll
        for (int r = 0; r < 12; ++r) { const int tt = t0 + r - 2; xin[r] = (u32x4){0u, 0u, 0u, 0u}; if (tt >= 0 && tt < L) xin[r] = *(const u32x4*)(PROJ + (size_t)(base + tt) * NPJ + 4096 + ch); }
        float wk[5][8], bia[8];
#pragma unroll
        for (int k = 0; k < 5; ++k) { const f32x4 a = *(const f32x4*)(cw + k * 1536 + ch), c = *(const f32x4*)(cw + k * 1536 + ch + 4); wk[k][0] = a.x; wk[k][1] = a.y; wk[k][2] = a.z; wk[k][3] = a.w; wk[k][4] = c.x; wk[k][5] = c.y; wk[k][6] = c.z; wk[k][7] = c.w; }
        { const f32x4 a = *(const f32x4*)(cb + ch), c = *(const f32x4*)(cb + ch + 4); bia[0] = a.x; bia[1] = a.y; bia[2] = a.z; bia[3] = a.w; bia[4] = c.x; bia[5] = c.y; bia[6] = c.z; bia[7] = c.w; }
        float out[8][8];
#pragma unroll
        for (int o = 0; o < 8; ++o) {
#pragma unroll
            for (int e = 0; e < 8; ++e) out[o][e] = bia[e];
#pragma unroll
            for (int k = 0; k < 5; ++k) { const u32x4 w = xin[o + k];
                out[o][0] += wk[k][0] * bflo(w.x); out[o][1] += wk[k][1] * bfhi(w.x); out[o][2] += wk[k][2] * bflo(w.y); out[o][3] += wk[k][3] * bfhi(w.y);
                out[o][4] += wk[k][4] * bflo(w.z); out[o][5] += wk[k][5] * bfhi(w.z); out[o][6] += wk[k][6] * bflo(w.w); out[o][7] += wk[k][7] * bfhi(w.w); }
#pragma unroll
            for (int e = 0; e < 8; ++e) out[o][e] = fast_silu(out[o][e]);
            *(u32x4*)(XBC + (size_t)(row0 + o) * 1536 + ch) = (u32x4){cvt_pk_bf16(out[o][0], out[o][1]), cvt_pk_bf16(out[o][2], out[o][3]), cvt_pk_bf16(out[o][4], out[o][5]), cvt_pk_bf16(out[o][6], out[o][7])};
        }
        if (ch < 1280) {
            bf16_t* T = ch < 1024 ? WSP(bf16_t, WS_XST) + ((size_t)b * 1024 + ch) * TOKS + tok0 : WSP(bf16_t, WS_BMT) + ((size_t)b * 256 + (ch - 1024)) * TOKS + tok0;
#pragma unroll
            for (int e = 0; e < 8; ++e) *(u32x4*)(T + (size_t)e * TOKS) = (u32x4){cvt_pk_bf16(out[0][e], out[1][e]), cvt_pk_bf16(out[2][e], out[3][e]), cvt_pk_bf16(out[4][e], out[5][e]), cvt_pk_bf16(out[6][e], out[7][e])};
        }
    }
}
__device__ __forceinline__ int chunk_row0(int b, int cc) { return cc < 2 ? ML + b * 256 + cc * 128 : b * 4096 + (cc - 2) * 128; }
__device__ __forceinline__ void chunk_prefix(float a0, float a1, int lane, float& p0, float& p1, float& tot) {
    float s = a0 + a1;
#pragma unroll
    for (int o = 1; o < 64; o <<= 1) { const float t = __int_as_float(__builtin_amdgcn_ds_bpermute((lane - o) << 2, __float_as_int(s))); if (lane >= o) s += t; }
    p1 = s; p0 = s - a1; tot = __int_as_float(__builtin_amdgcn_readlane(__float_as_int(s), 63));
}
__device__ __forceinline__ void ssd1_job(KArgsPtr KA, Frame& F, int job, int lane_, int wave) {
    int lane = lane_; asm volatile("" : "+v"(lane));
    const float* DT = WSP(float, WS_DT); const float* DA = WSP(float, WS_DA); const bf16_t* XST = WSP(bf16_t, WS_XST); const bf16_t* BMT = WSP(bf16_t, WS_BMT);
    float* SST = WSP(float, WS_SST); float* DEC = WSP(float, WS_DEC);
    LAS float* wtab = (LAS float*)(F.lds + wave * 16384);
    const int l15 = lane & 15, q = lane >> 4;
    {
        const int head = job & 15, cc = (job >> 4) % NCC, b = job / (16 * NCC), g = head >> 3, row0 = chunk_row0(b, cc), tokb = cc * 128;
        { const int r = row0 + 2 * lane;
          const float af0 = DA[(size_t)r * 32 + head], af1 = DA[(size_t)(r + 1) * 32 + head], ab0 = DA[(size_t)r * 32 + 16 + head], ab1 = DA[(size_t)(r + 1) * 32 + 16 + head];
          const float df0 = DT[(size_t)r * 32 + head], df1 = DT[(size_t)(r + 1) * 32 + head], db0 = DT[(size_t)r * 32 + 16 + head], db1 = DT[(size_t)(r + 1) * 32 + 16 + head];
          float pf0, pf1, tf, pb0, pb1, tb; chunk_prefix(af0, af1, lane, pf0, pf1, tf); chunk_prefix(ab0, ab1, lane, pb0, pb1, tb);
          wtab[2 * lane] = __expf(tf - pf0) * df0; wtab[2 * lane + 1] = __expf(tf - pf1) * df1;
          wtab[128 + 2 * lane] = __expf(pb0 - ab0) * db0; wtab[128 + 2 * lane + 1] = __expf(pb1 - ab1) * db1;
          if (lane == 0) { DEC[(size_t)(b * NCC + cc) * 32 + head] = __expf(tf); DEC[(size_t)(b * NCC + cc) * 32 + 16 + head] = __expf(tb); } }
        asm volatile("s_waitcnt lgkmcnt(0)" ::: "memory");
        bf16x8 xa[4][4];
#pragma unroll
        for (int pt = 0; pt < 4; ++pt)
#pragma unroll
            for (int ks = 0; ks < 4; ++ks) xa[pt][ks] = *(const bf16x8*)(XST + ((size_t)b * 1024 + head * 64 + 16 * pt + l15) * TOKS + tokb + 32 * ks + 8 * q);
        float wf[4][8], wb[4][8];
#pragma unroll
        for (int ks = 0; ks < 4; ++ks) { const f32x4 a = *(const LAS f32x4*)(wtab + 32 * ks + 8 * q), c = *(const LAS f32x4*)(wtab + 32 * ks + 8 * q + 4), d = *(const LAS f32x4*)(wtab + 128 + 32 * ks + 8 * q), e = *(const LAS f32x4*)(wtab + 128 + 32 * ks + 8 * q + 4);
            wf[ks][0] = a.x; wf[ks][1] = a.y; wf[ks][2] = a.z; wf[ks][3] = a.w; wf[ks][4] = c.x; wf[ks][5] = c.y; wf[ks][6] = c.z; wf[ks][7] = c.w;
            wb[ks][0] = d.x; wb[ks][1] = d.y; wb[ks][2] = d.z; wb[ks][3] = d.w; wb[ks][4] = e.x; wb[ks][5] = e.y; wb[ks][6] = e.z; wb[ks][7] = e.w; }
        float* So = SST + ((size_t)((b * NCC + cc) * 2) * 16 + head) * 8192;
        const bf16_t* bbase = BMT + ((size_t)b * 256 + g * 128 + l15) * TOKS + tokb + 8 * q;
        u32x4 bw[4], bn[4];
#pragma unroll
        for (int ks = 0; ks < 4; ++ks) bw[ks] = *(const u32x4*)(bbase + 32 * ks);
#pragma unroll 1
        for (int nt = 0; nt < 8; ++nt) {
            if (nt < 7) {
#pragma unroll
                for (int ks = 0; ks < 4; ++ks) bn[ks] = *(const u32x4*)(bbase + (size_t)16 * (nt + 1) * TOKS + 32 * ks);
            }
            f32x4 af[4], ab[4];
#pragma unroll
            for (int pt = 0; pt < 4; ++pt) { af[pt] = (f32x4){0.f, 0.f, 0.f, 0.f}; ab[pt] = af[pt]; }
#pragma unroll
            for (int ks = 0; ks < 4; ++ks) {
                const float bv[8] = {bflo(bw[ks].x), bfhi(bw[ks].x), bflo(bw[ks].y), bfhi(bw[ks].y), bflo(bw[ks].z), bfhi(bw[ks].z), bflo(bw[ks].w), bfhi(bw[ks].w)};
                const u32x4 ff = {cvt_pk_bf16(bv[0] * wf[ks][0], bv[1] * wf[ks][1]), cvt_pk_bf16(bv[2] * wf[ks][2], bv[3] * wf[ks][3]), cvt_pk_bf16(bv[4] * wf[ks][4], bv[5] * wf[ks][5]), cvt_pk_bf16(bv[6] * wf[ks][6], bv[7] * wf[ks][7])};
                const u32x4 fb = {cvt_pk_bf16(bv[0] * wb[ks][0], bv[1] * wb[ks][1]), cvt_pk_bf16(bv[2] * wb[ks][2], bv[3] * wb[ks][3]), cvt_pk_bf16(bv[4] * wb[ks][4], bv[5] * wb[ks][5]), cvt_pk_bf16(bv[6] * wb[ks][6], bv[7] * wb[ks][7])};
                const bf16x8 frf = __builtin_bit_cast(bf16x8, ff), frb = __builtin_bit_cast(bf16x8, fb);
#pragma unroll
                for (int pt = 0; pt < 4; ++pt) { af[pt] = __builtin_amdgcn_mfma_f32_16x16x32_bf16(xa[pt][ks], frf, af[pt], 0, 0, 0); ab[pt] = __builtin_amdgcn_mfma_f32_16x16x32_bf16(xa[pt][ks], frb, ab[pt], 0, 0, 0); }
            }
#pragma unroll
            for (int pt = 0; pt < 4; ++pt)
#pragma unroll
                for (int r = 0; r < 4; ++r) { const int pp = 16 * pt + 4 * q + r, n = 16 * nt + l15; So[(size_t)pp * 128 + n] = af[pt][r]; So[(size_t)16 * 8192 + (size_t)pp * 128 + n] = ab[pt][r]; }
#pragma unroll
            for (int ks = 0; ks < 4; ++ks) bw[ks] = bn[ks];
        }
        asm volatile("s_waitcnt lgkmcnt(0)" ::: "memory");
    }
}
__device__ __forceinline__ void ph_scan(Frame& F) {
    PHASE_IDS();
    const float* SST = WSP(float, WS_SST); const float* DEC = WSP(float, WS_DEC); bf16_t* HIN = WSP(bf16_t, WS_HIN);
    const int idx = vcu_ * NTHR + tid;
    if (idx < 2 * 2 * 16 * 2048) {
        const int e4 = idx & 2047, head = (idx >> 11) & 15, dir = (idx >> 15) & 1, b = idx >> 16;
        f32x4 h = {0.f, 0.f, 0.f, 0.f};
#pragma unroll 1
        for (int q0 = 0; q0 < NCC; q0 += 17) {
            f32x4 sv[17]; float dv[17];
#pragma unroll
            for (int k = 0; k < 17; ++k) { const int qq = q0 + k; const int cc = dir == 0 ? qq : (qq == 0 ? 1 : (qq == 1 ? 0 : 35 - qq));
                const size_t o = ((size_t)((b * NCC + cc) * 2 + dir) * 16 + head) * 8192 + e4 * 4;
                sv[k] = *(const f32x4*)(SST + o); dv[k] = DEC[(size_t)(b * NCC + cc) * 32 + dir * 16 + head]; }
            asm volatile("" ::: "memory");
#pragma unroll
            for (int k = 0; k < 17; ++k) { const int qq = q0 + k; const int cc = dir == 0 ? qq : (qq == 0 ? 1 : (qq == 1 ? 0 : 35 - qq));
                const size_t o = ((size_t)((b * NCC + cc) * 2 + dir) * 16 + head) * 8192 + e4 * 4;
                *(u32x2*)(HIN + o) = (u32x2){cvt_pk_bf16(h.x, h.y), cvt_pk_bf16(h.z, h.w)};
                h = h * dv[k] + sv[k]; }
        }
    }
}
__device__ __forceinline__ void ph_ssd3(Frame& F, int j, int cc_lo) {
    PHASE_IDS();
    const float* DT = WSP(float, WS_DT); const float* DA = WSP(float, WS_DA); const bf16_t* XST = WSP(bf16_t, WS_XST); const bf16_t* XBC = WSP(bf16_t, WS_XBC);
    const bf16_t* HIN = WSP(bf16_t, WS_HIN); float* Y = WSP(float, WS_YF); const float* ssd_d = KA->in[18] + j * 16;
    LAS float* tab = (LAS float*)(F.lds + wave * 16384);
    const int l15 = lane & 15, q = lane >> 4, ncc = NCC - cc_lo;
    const int jrow = 8 * (l15 >> 2) + (l15 & 3);
    for (int job = gw; job < 2 * ncc * 32; job += NGW) {
        const int half = job & 1, head = (job >> 1) & 15, cc = cc_lo + (job >> 5) % ncc, b = job / (32 * ncc), g = head >> 3, row0 = chunk_row0(b, cc), tokb = cc * 128;
        { const int r = row0 + 2 * lane;
          const float af0 = DA[(size_t)r * 32 + head], af1 = DA[(size_t)(r + 1) * 32 + head], ab0 = DA[(size_t)r * 32 + 16 + head], ab1 = DA[(size_t)(r + 1) * 32 + 16 + head];
          float pf0, pf1, tf, pb0, pb1, tb; chunk_prefix(af0, af1, lane, pf0, pf1, tf); chunk_prefix(ab0, ab1, lane, pb0, pb1, tb);
          tab[2 * lane] = pf0; tab[2 * lane + 1] = pf1; tab[128 + 2 * lane] = tb - pb0 + ab0; tab[128 + 2 * lane + 1] = tb - pb1 + ab1;
          tab[256 + 2 * lane] = DT[(size_t)r * 32 + head]; tab[256 + 2 * lane + 1] = DT[(size_t)(r + 1) * 32 + head];
          tab[384 + 2 * lane] = DT[(size_t)r * 32 + 16 + head]; tab[384 + 2 * lane + 1] = DT[(size_t)(r + 1) * 32 + 16 + head]; }
        asm volatile("s_waitcnt lgkmcnt(0)" ::: "memory");
        const float dsk = ssd_d[head];
        const bf16_t* hin_f = HIN + ((size_t)((b * NCC + cc) * 2 + 0) * 16 + head) * 8192 + (size_t)l15 * 128 + 8 * q; const bf16_t* hin_b = hin_f + (size_t)16 * 8192;
        const bf16_t* xst = XST + ((size_t)b * 1024 + head * 64 + l15) * TOKS + tokb + 8 * q;
        const bf16_t* bmr = XBC + (size_t)(row0 + jrow) * 1536 + 1024 + g * 128 + 8 * q;
        const LAS float* tq = tab + 8 * q;
#pragma unroll 1
        for (int ip = 0; ip < 2; ++ip) {
            const int ib0 = half * 4 + ip * 2;
            const int i0 = 16 * ib0 + l15, i1 = i0 + 16;
            const float P0 = tab[i0], S0 = tab[128 + i0], P1 = tab[i1], S1 = tab[128 + i1];
            const bf16_t* crow0 = XBC + (size_t)(row0 + i0) * 1536 + 1280 + g * 128 + 8 * q; const bf16_t* crow1 = crow0 + (size_t)16 * 1536;
            bf16x8 cf0[4], cf1[4];
#pragma unroll
            for (int ks = 0; ks < 4; ++ks) { cf0[ks] = *(const bf16x8*)(crow0 + 32 * ks); cf1[ks] = *(const bf16x8*)(crow1 + 32 * ks); }
            f32x4 y0[4], y1[4];
#pragma unroll
            for (int pt = 0; pt < 4; ++pt) { y0[pt] = (f32x4){0.f, 0.f, 0.f, 0.f}; y1[pt] = y0[pt]; }
            const int dq = 8 * q - l15;
#pragma unroll 1
            for (int kk = 0; kk < 4; ++kk) {
                f32x4 ga0 = {0.f, 0.f, 0.f, 0.f}, gb0 = ga0, ga1 = ga0, gb1 = ga0;
                bf16x8 bfa[4], bfb[4], xfr[4];
#pragma unroll
                for (int ks = 0; ks < 4; ++ks) { bfa[ks] = *(const bf16x8*)(bmr + (size_t)(32 * kk) * 1536 + 32 * ks); bfb[ks] = *(const bf16x8*)(bmr + (size_t)(32 * kk + 4) * 1536 + 32 * ks); }
#pragma unroll
                for (int pt = 0; pt < 4; ++pt) xfr[pt] = *(const bf16x8*)(xst + (size_t)16 * pt * TOKS + 32 * kk);
#pragma unroll
                for (int ks = 0; ks < 4; ++ks) { const bf16x8 ba = bfa[ks], bb = bfb[ks];
                    ga0 = __builtin_amdgcn_mfma_f32_16x16x32_bf16(ba, cf0[ks], ga0, 0, 0, 0); gb0 = __builtin_amdgcn_mfma_f32_16x16x32_bf16(bb, cf0[ks], gb0, 0, 0, 0);
                    ga1 = __builtin_amdgcn_mfma_f32_16x16x32_bf16(ba, cf1[ks], ga1, 0, 0, 0); gb1 = __builtin_amdgcn_mfma_f32_16x16x32_bf16(bb, cf1[ks], gb1, 0, 0, 0); }
                const LAS float* tj = tq + 32 * kk;
                const f32x4 Pa = *(const LAS f32x4*)(tj), Pb = *(const LAS f32x4*)(tj + 4), Sa = *(const LAS f32x4*)(tj + 128), Sb = *(const LAS f32x4*)(tj + 132);
                const f32x4 fa = *(const LAS f32x4*)(tj + 256), fb = *(const LAS f32x4*)(tj + 260), ba2 = *(const LAS f32x4*)(tj + 384), bb2 = *(const LAS f32x4*)(tj + 388);
                const float Pj[8] = {Pa.x, Pa.y, Pa.z, Pa.w, Pb.x, Pb.y, Pb.z, Pb.w}, Sj[8] = {Sa.x, Sa.y, Sa.z, Sa.w, Sb.x, Sb.y, Sb.z, Sb.w};
                const float dfj[8] = {fa.x, fa.y, fa.z, fa.w, fb.x, fb.y, fb.z, fb.w}, dbj[8] = {ba2.x, ba2.y, ba2.z, ba2.w, bb2.x, bb2.y, bb2.z, bb2.w};
                const int dj0 = 32 * kk - 16 * ib0 + dq;
                float m0[8], m1[8];
#pragma unroll
                for (int e = 0; e < 8; ++e) { const int d0 = dj0 + e, d1 = d0 - 16;
                    const float g0v = e < 4 ? ga0[e & 3] : gb0[e & 3], g1v = e < 4 ? ga1[e & 3] : gb1[e & 3];
                    const float w0 = (d0 <= 0 ? __expf(fminf(P0 - Pj[e], 0.f)) * dfj[e] : 0.f) + (d0 >= 0 ? __expf(fminf(S0 - Sj[e], 0.f)) * dbj[e] : 0.f);
                    const float w1 = (d1 <= 0 ? __expf(fminf(P1 - Pj[e], 0.f)) * dfj[e] : 0.f) + (d1 >= 0 ? __expf(fminf(S1 - Sj[e], 0.f)) * dbj[e] : 0.f);
                    m0[e] = g0v * w0; m1[e] = g1v * w1; }
                const bf16x8 mf0 = __builtin_bit_cast(bf16x8, ((u32x4){cvt_pk_bf16(m0[0], m0[1]), cvt_pk_bf16(m0[2], m0[3]), cvt_pk_bf16(m0[4], m0[5]), cvt_pk_bf16(m0[6], m0[7])}));
                const bf16x8 mf1 = __builtin_bit_cast(bf16x8, ((u32x4){cvt_pk_bf16(m1[0], m1[1]), cvt_pk_bf16(m1[2], m1[3]), cvt_pk_bf16(m1[4], m1[5]), cvt_pk_bf16(m1[6], m1[7])}));
#pragma unroll
                for (int pt = 0; pt < 4; ++pt) { const bf16x8 xf = xfr[pt];
                    y0[pt] = __builtin_amdgcn_mfma_f32_16x16x32_bf16(xf, mf0, y0[pt], 0, 0, 0); y1[pt] = __builtin_amdgcn_mfma_f32_16x16x32_bf16(xf, mf1, y1[pt], 0, 0, 0); }
            }
            const float ef0 = __expf(P0), eb0 = __expf(S0), ef1 = __expf(P1), eb1 = __expf(S1);
#pragma unroll
            for (int pt = 0; pt < 4; ++pt) {
                f32x4 of0 = {0.f, 0.f, 0.f, 0.f}, ob0 = of0, of1 = of0, ob1 = of0;
#pragma unroll
                for (int ks = 0; ks < 4; ++ks) { const bf16x8 hf = *(const bf16x8*)(hin_f + (size_t)16 * pt * 128 + 32 * ks), hb = *(const bf16x8*)(hin_b + (size_t)16 * pt * 128 + 32 * ks);
                    of0 = __builtin_amdgcn_mfma_f32_16x16x32_bf16(hf, cf0[ks], of0, 0, 0, 0); ob0 = __builtin_amdgcn_mfma_f32_16x16x32_bf16(hb, cf0[ks], ob0, 0, 0, 0);
                    of1 = __builtin_amdgcn_mfma_f32_16x16x32_bf16(hf, cf1[ks], of1, 0, 0, 0); ob1 = __builtin_amdgcn_mfma_f32_16x16x32_bf16(hb, cf1[ks], ob1, 0, 0, 0); }
                const u32x2 xw0 = *(const u32x2*)(XBC + (size_t)(row0 + i0) * 1536 + head * 64 + 16 * pt + 4 * q), xw1 = *(const u32x2*)(XBC + (size_t)(row0 + i1) * 1536 + head * 64 + 16 * pt + 4 * q);
                f32x4 v0 = y0[pt] + of0 * ef0 + ob0 * eb0, v1 = y1[pt] + of1 * ef1 + ob1 * eb1;
                v0.x += dsk * bflo(xw0.x); v0.y += dsk * bfhi(xw0.x); v0.z += dsk * bflo(xw0.y); v0.w += dsk * bfhi(xw0.y);
                v1.x += dsk * bflo(xw1.x); v1.y += dsk * bfhi(xw1.x); v1.z += dsk * bflo(xw1.y); v1.w += dsk * bfhi(xw1.y);
                *(f32x4*)(Y + (size_t)(row0 + i0) * 1024 + head * 64 + 16 * pt + 4 * q) = v0;
                *(f32x4*)(Y + (size_t)(row0 + i1) * 1024 + head * 64 + 16 * pt + 4 * q) = v1;
            }
        }
        asm volatile("s_waitcnt lgkmcnt(0)" ::: "memory");
    }
}

__device__ __forceinline__ unsigned w4(const u32x4& v, int i) { return i == 0 ? v.x : (i == 1 ? v.y : (i == 2 ? v.z : v.w)); }
__device__ __forceinline__ void ph_vt(Frame& F) {
    PHASE_IDS();
    const bf16_t* PROJ = WSP(bf16_t, WS_PROJ); bf16_t* VT = WSP(bf16_t, WS_VT);
    for (int wit = gw; wit < (MT / 64) * 16; wit += NGW) {
        const int rg = (wit >> 4) * 8 + (lane & 7), ch = (wit & 15) * 64 + (lane >> 3) * 8, row0 = rg * 8;
        int b, tok0; if (row0 < ML) { b = row0 >> 12; tok0 = row0 & 4095; } else { const int rr = row0 - ML; b = rr >> 8; tok0 = 4096 + (rr & 255); }
        u32x4 in[8];
#pragma unroll
        for (int r = 0; r < 8; ++r) in[r] = MK_NT_X ? __builtin_nontemporal_load((const u32x4*)(PROJ + (size_t)(row0 + r) * NPJ + 2048 + ch)) : *(const u32x4*)(PROJ + (size_t)(row0 + r) * NPJ + 2048 + ch);
        bf16_t* dst = VT + ((size_t)(b * 8 + (ch >> 7)) * 128 + (ch & 127)) * VTP + tok0;
#pragma unroll
        for (int e = 0; e < 8; ++e) { const unsigned sel = (e & 1) ? 0x07060302u : 0x05040100u; const int w = e >> 1;
            const u32x4 o = {__builtin_amdgcn_perm(w4(in[1], w), w4(in[0], w), sel), __builtin_amdgcn_perm(w4(in[3], w), w4(in[2], w), sel), __builtin_amdgcn_perm(w4(in[5], w), w4(in[4], w), sel), __builtin_amdgcn_perm(w4(in[7], w), w4(in[6], w), sel)};
            *(u32x4*)(dst + (size_t)e * VTP) = o; }
    }
}
__device__ __forceinline__ void attn_job(KArgsPtr KA, Frame& F, int job, int j, int lane_, int wave) {
    int lane = lane_; asm volatile("" : "+v"(lane));
    const bf16_t* QP = WSP(bf16_t, WS_QP); const bf16_t* QR = WSP(bf16_t, WS_QR); const bf16_t* KR = WSP(bf16_t, WS_KR); const bf16_t* VT = WSP(bf16_t, WS_VT);
    const float* rpb = KA->in[13] + j * 8 * 15 * 31; bf16_t* MIX = WSP(bf16_t, WS_MIX);
    const int l15 = lane & 15, qq = lane >> 4;
    const float SC = 0.08838834764831845f * LOG2E;
    const bool lat = job < 2048;
    int b, h, qrowA, qrowB, rA = 0, cg = 0;
    if (lat) { cg = job & 3; rA = ((job >> 2) & 31) * 2; h = (job >> 7) & 7; b = job >> 10; qrowA = b * 4096 + rA * 64 + 16 * cg + l15; qrowB = qrowA + 64; }
    else { const int jj = job - 2048; h = (jj >> 3) & 7; b = jj >> 6; qrowA = ML + b * 256 + 32 * (jj & 7) + l15; qrowB = qrowA + 16; }
    LAS float* btab = (LAS float*)(F.lds + wave * 16384 + 2048);
    if (lat) {
        float bt[8];
#pragma unroll
        for (int i = 0; i < 8; ++i) { const int idx = lane + 64 * i; bt[i] = rpb[h * 465 + (idx < 465 ? idx : 464)]; }
        asm volatile("" ::: "memory");
#pragma unroll
        for (int i = 0; i < 8; ++i) { const int idx = lane + 64 * i; if (idx < 465) btab[idx] = bt[i] * LOG2E; }
    }
    int r0A = rA - 4; r0A = r0A < 0 ? 0 : (r0A > 56 ? 56 : r0A);
    int r0B = rA - 3; r0B = r0B < 0 ? 0 : (r0B > 56 ? 56 : r0B);
    const int nwin = lat ? (r0B + 8 - r0A) : 0;
    const int s0 = cg == 0 ? 0 : (cg == 1 ? 8 : (cg == 2 ? 24 : 32)), qcol = 16 * cg + l15;
    int c0 = qcol - 8; c0 = c0 < 0 ? 0 : (c0 > 48 ? 48 : c0);
    f32x4 oA[8], oB[8];
#pragma unroll
    for (int dt = 0; dt < 8; ++dt) { oA[dt] = (f32x4){0.f, 0.f, 0.f, 0.f}; oB[dt] = oA[dt]; }
    float mA = -INFINITY, lA = 0.f, mB = -INFINITY, lB = 0.f;
    const int krl = 8 * (l15 >> 2) + (l15 & 3);
    const bf16_t* vt = VT + (size_t)(b * 8 + h) * 128 * VTP + (size_t)l15 * VTP + 8 * qq;
    const bf16_t* kwin = KR + (size_t)(b * 4096 + r0A * 64 + s0 + krl) * KRP + h * 128 + 8 * qq;
    const bf16_t* kctx = KR + (size_t)(ML + b * 256 + krl) * KRP + h * 128 + 8 * qq;
    bf16x8 qA[4], qB[4];
    const size_t qoa = (size_t)qrowA * 1024 + h * 128 + 8 * qq, qob = (size_t)qrowB * 1024 + h * 128 + 8 * qq;
#pragma unroll
    for (int ks = 0; ks < 4; ++ks) { qA[ks] = *(const bf16x8*)(QR + qoa + 32 * ks); qB[ks] = *(const bf16x8*)(QR + qob + 32 * ks); }
    asm volatile("s_waitcnt lgkmcnt(0)" ::: "memory");
    const int nstep = nwin + 8;
#pragma unroll 1
    for (int step = 0; step < nstep; ++step) {
        const bool win = step < nwin;
        if (step == nwin) {
#pragma unroll
            for (int ks = 0; ks < 4; ++ks) { qA[ks] = *(const bf16x8*)(QP + qoa + 32 * ks); qB[ks] = *(const bf16x8*)(QP + qob + 32 * ks); }
        }
        const bf16_t* kp = win ? kwin + (size_t)step * 64 * KRP : kctx + (size_t)(step - nwin) * 32 * KRP;
        bf16x8 kc[8];
#pragma unroll
        for (int ks = 0; ks < 4; ++ks) { kc[ks] = *(const bf16x8*)(kp + 32 * ks); kc[4 + ks] = *(const bf16x8*)(kp + 4 * KRP + 32 * ks); }
        const bf16_t* vb = vt + (win ? (r0A + step) * 64 + s0 : 4096 + 32 * (step - nwin));
        bf16x8 vx[8];
#pragma unroll
        for (int dt = 0; dt < 8; ++dt) vx[dt] = *(const bf16x8*)(vb + (size_t)16 * dt * VTP);
        f32x4 sa0 = {0.f, 0.f, 0.f, 0.f}, sa1 = sa0, sb0 = sa0, sb1 = sa0;
#pragma unroll
        for (int ks = 0; ks < 4; ++ks) { sa0 = __builtin_amdgcn_mfma_f32_16x16x32_bf16(kc[ks], qA[ks], sa0, 0, 0, 0); sa1 = __builtin_amdgcn_mfma_f32_16x16x32_bf16(kc[4 + ks], qA[ks], sa1, 0, 0, 0);
                                         sb0 = __builtin_amdgcn_mfma_f32_16x16x32_bf16(kc[ks], qB[ks], sb0, 0, 0, 0); sb1 = __builtin_amdgcn_mfma_f32_16x16x32_bf16(kc[4 + ks], qB[ks], sb1, 0, 0, 0); }
        float svA[8], svB[8];
        if (win) {
            const int krow = r0A + step;
            const bool rowA = krow < r0A + 8, rowB = krow >= r0B;
            const LAS float* browA = btab + (krow - rA + 7) * 31 + 15; const LAS float* browB = browA - 31;
            float bs[8];
#pragma unroll
            for (int e = 0; e < 8; ++e) { int dc = s0 + 8 * qq + e - qcol; dc = dc < -15 ? -15 : (dc > 15 ? 15 : dc); bs[e] = rowA ? browA[dc] : 0.f; }
#pragma unroll
            for (int e = 0; e < 8; ++e) { const int kcn = s0 + 8 * qq + e; const bool okc = kcn >= c0 && kcn < c0 + 16;
                svA[e] = (okc && rowA) ? (e < 4 ? sa0[e & 3] : sa1[e & 3]) * SC + bs[e] : -INFINITY; }
#pragma unroll
            for (int e = 0; e < 8; ++e) { int dc = s0 + 8 * qq + e - qcol; dc = dc < -15 ? -15 : (dc > 15 ? 15 : dc); bs[e] = rowB ? browB[dc] : 0.f; }
#pragma unroll
            for (int e = 0; e < 8; ++e) { const int kcn = s0 + 8 * qq + e; const bool okc = kcn >= c0 && kcn < c0 + 16;
                svB[e] = (okc && rowB) ? (e < 4 ? sb0[e & 3] : sb1[e & 3]) * SC + bs[e] : -INFINITY; }
        } else {
#pragma unroll
            for (int e = 0; e < 8; ++e) { svA[e] = (e < 4 ? sa0[e & 3] : sa1[e & 3]) * SC; svB[e] = (e < 4 ? sb0[e & 3] : sb1[e & 3]) * SC; }
        }
#define ATT_SOFTMAX(sv, m, l, o) do { \
        float tmax = fmaxf(fmaxf(fmaxf(sv[0], sv[1]), fmaxf(sv[2], sv[3])), fmaxf(fmaxf(sv[4], sv[5]), fmaxf(sv[6], sv[7]))); \
        tmax = fmaxf(tmax, shx(tmax, 16, lane)); tmax = fmaxf(tmax, shx(tmax, 32, lane)); \
        const float mn = fmaxf(m, tmax), mref = mn == -INFINITY ? 0.f : mn, alpha = __builtin_amdgcn_exp2f(m - mref); m = mn; \
        float pe[8]; float ps = 0.f; \
        _Pragma("unroll") for (int e = 0; e < 8; ++e) { pe[e] = __builtin_amdgcn_exp2f(sv[e] - mref); ps += pe[e]; } \
        l = l * alpha + ps; \
        const bf16x8 pfrag = __builtin_bit_cast(bf16x8, ((u32x4){cvt_pk_bf16(pe[0], pe[1]), cvt_pk_bf16(pe[2], pe[3]), cvt_pk_bf16(pe[4], pe[5]), cvt_pk_bf16(pe[6], pe[7])})); \
        _Pragma("unroll") for (int dt = 0; dt < 8; ++dt) { o[dt] = o[dt] * alpha; o[dt] = __builtin_amdgcn_mfma_f32_16x16x32_bf16(vx[dt], pfrag, o[dt], 0, 0, 0); } } while (0)
        ATT_SOFTMAX(svA, mA, lA, oA);
        ATT_SOFTMAX(svB, mB, lB, oB);
#undef ATT_SOFTMAX
    }
    lA += shx(lA, 16, lane); lA += shx(lA, 32, lane); lB += shx(lB, 16, lane); lB += shx(lB, 32, lane);
    const float invA = 1.0f / lA, invB = 1.0f / lB;
#pragma unroll
    for (int dt = 0; dt < 8; ++dt) { const f32x4 va = oA[dt] * invA, vb2 = oB[dt] * invB;
        *(u32x2*)(MIX + (size_t)qrowA * D + h * 128 + 16 * dt + 4 * qq) = (u32x2){cvt_pk_bf16(va.x, va.y), cvt_pk_bf16(va.z, va.w)};
        *(u32x2*)(MIX + (size_t)qrowB * D + h * 128 + 16 * dt + 4 * qq) = (u32x2){cvt_pk_bf16(vb2.x, vb2.y), cvt_pk_bf16(vb2.z, vb2.w)}; }
    asm volatile("s_waitcnt lgkmcnt(0)" ::: "memory");
}
__device__ __forceinline__ void ph_ssd1_attn(Frame& F, int j, int with_ctxq, int sub) {
    PHASE_IDS();
    const int n1 = 2 * NCC * 16, njobs = sub == 1 ? n1 : n1 + 2048 + (with_ctxq ? 128 : 0);
    for (int t = gw + (sub == 2 ? n1 : 0); t < njobs; t += NGW) {
        if (t < n1) ssd1_job(KA, F, t, lane, wave);
        else attn_job(KA, F, t - n1, j, lane, wave);
    }
}
__device__ __forceinline__ void ph_attn_naive(Frame& F, int j, int nrows) {
    PHASE_IDS();
    const bf16_t* QP = WSP(bf16_t, WS_QP); const bf16_t* QR = WSP(bf16_t, WS_QR); const bf16_t* KR = WSP(bf16_t, WS_KR); const bf16_t* PROJ = WSP(bf16_t, WS_PROJ);
    const float* rpb = KA->in[13] + j * 8 * 15 * 31; bf16_t* MIX = WSP(bf16_t, WS_MIX);
    LAS float* sq = (LAS float*)(F.lds + wave * 16384);
    LAS float* sp = sq + 256;
    LAS int* skey = (LAS int*)(sp + 384);
    for (int it = gw; it < nrows * 8; it += NGW) {
        const int row = it >> 3, h = it & 7;
        sq[lane] = bf2f(QR[(size_t)row * 1024 + h * 128 + lane]); sq[lane + 64] = bf2f(QR[(size_t)row * 1024 + h * 128 + lane + 64]);
        sq[128 + lane] = bf2f(QP[(size_t)row * 1024 + h * 128 + lane]); sq[128 + lane + 64] = bf2f(QP[(size_t)row * 1024 + h * 128 + lane + 64]);
        asm volatile("s_waitcnt lgkmcnt(0)" ::: "memory");
        const bool lat = row < ML; const int b = lat ? (row >> 12) : ((row - ML) >> 8);
        const int nk = lat ? 384 : 256; const int t = row & 4095, r = t >> 6, qc = t & 63;
        int r0 = r - 4; r0 = r0 < 0 ? 0 : (r0 > 56 ? 56 : r0);
        int c0 = qc - 8; c0 = c0 < 0 ? 0 : (c0 > 48 ? 48 : c0);
        float mx = -INFINITY;
        for (int i = lane; i < nk; i += 64) {
            int key; float bias = 0.f; int qsel = 128;
            if (lat && i < 128) { const int kr = r0 + (i >> 4), kc = c0 + (i & 15); key = b * 4096 + kr * 64 + kc; int dc = kc - qc; dc = dc < -15 ? -15 : (dc > 15 ? 15 : dc);
                bias = rpb[(h * 15 + (kr - r + 7)) * 31 + dc + 15]; qsel = 0; }
            else key = ML + b * 256 + (lat ? i - 128 : i);
            const u32x4* kp = (const u32x4*)(KR + (size_t)key * 1024 + h * 128); float d = 0.f;
#pragma unroll 4
            for (int e = 0; e < 16; ++e) { const u32x4 w = kp[e]; const LAS float* q = sq + qsel + e * 8;
                d += q[0] * bflo(w.x) + q[1] * bfhi(w.x) + q[2] * bflo(w.y) + q[3] * bfhi(w.y) + q[4] * bflo(w.z) + q[5] * bfhi(w.z) + q[6] * bflo(w.w) + q[7] * bfhi(w.w); }
            const float s = d * 0.08838834764831845f + bias; sp[i] = s; skey[i] = key; mx = fmaxf(mx, s);
        }
        mx = wave_max(mx, lane);
        float sum = 0.f;
        for (int i = lane; i < nk; i += 64) { const float e = __expf(sp[i] - mx); sp[i] = e; sum += e; }
        sum = wave_sum(sum, lane);
        asm volatile("s_waitcnt lgkmcnt(0)" ::: "memory");
        float o0 = 0.f, o1 = 0.f;
        for (int i = 0; i < nk; ++i) { const bf16_t* vp = PROJ + (size_t)skey[i] * NPJ + 2048 + h * 128; const float pv = sp[i]; o0 += pv * bf2f(vp[lane]); o1 += pv * bf2f(vp[lane + 64]); }
        const float inv = 1.f / sum;
        MIX[(size_t)row * D + h * 128 + lane] = f2bf(o0 * inv); MIX[(size_t)row * D + h * 128 + lane + 64] = f2bf(o1 * inv);
        asm volatile("s_waitcnt lgkmcnt(0)" ::: "memory");
    }
}
__device__ __forceinline__ void ph_gated(Frame& F, int j, int nrows) {
    PHASE_IDS();
    const float* YF = WSP(float, WS_YF); const bf16_t* PROJ = WSP(bf16_t, WS_PROJ);
    const float* g = KA->in[19] + j * 1024; bf16_t* MIX = WSP(bf16_t, WS_MIX);
    for (int it = gw; it < nrows * 2; it += NGW) {
        const int row = it >> 1, grp = it & 1, ch = grp * 512 + lane * 8;
        const f32x4 yf0 = *(const f32x4*)(YF + (size_t)row * 1024 + ch), yf1 = *(const f32x4*)(YF + (size_t)row * 1024 + ch + 4);
        const u32x4 zw = *(const u32x4*)(PROJ + (size_t)row * NPJ + 3072 + ch);
        const float zs[8] = {bflo(zw.x), bfhi(zw.x), bflo(zw.y), bfhi(zw.y), bflo(zw.z), bfhi(zw.z), bflo(zw.w), bfhi(zw.w)};
        const float ys[8] = {yf0.x, yf0.y, yf0.z, yf0.w, yf1.x, yf1.y, yf1.z, yf1.w};
        float yz[8]; float ss = 0.f;
#pragma unroll
        for (int e = 0; e < 8; ++e) { yz[e] = ys[e] * fast_silu(zs[e]); ss += yz[e] * yz[e]; }
        const float r = 1.0f / sqrtf(wave_sum(ss, lane) * (1.f / 512.f) + EPS);
        const f32x4 g0 = *(const f32x4*)(g + ch), g1 = *(const f32x4*)(g + ch + 4);
        u32x4 o; o.x = cvt_pk_bf16(yz[0] * r * g0.x, yz[1] * r * g0.y); o.y = cvt_pk_bf16(yz[2] * r * g0.z, yz[3] * r * g0.w); o.z = cvt_pk_bf16(yz[4] * r * g1.x, yz[5] * r * g1.y); o.w = cvt_pk_bf16(yz[6] * r * g1.z, yz[7] * r * g1.w);
        *(u32x4*)(MIX + (size_t)row * D + 1024 + ch) = o;
    }
}

constexpr int PPL = 14, N_PHASES = 1 + 4 * PPL;

#ifndef MK_CTX_SPLIT
#define MK_CTX_SPLIT 1
#endif
#define MK_GEMM(EpiT, Eobj, Aptr, lda_, Bptr, ldb_, K_, M_, N_, Z_, zdiv_, zA1_, zA2_, zB1_, zB2_, cid_) do { \
    pg8::Gemm g_{(const bf16_t*)(Aptr), (const bf16_t*)(Bptr), (lda_), (ldb_), (K_), (zdiv_), (long)(zA1_), (long)(zA2_), (long)(zB1_), (long)(zB2_), (long)256 * (lda_), (long)256 * (ldb_)}; \
    pg8::Order S_; S_.init((M_), (N_), (Z_), G_, (cid_)); \
    pg8::gemm_phase<EpiT, (MK_ALIGN != 0)>(F.lds, g_, S_, Eobj); } while (0)

#define MK_GEMM_TS(EpiT, Eobj, Aptr, lda_, Bptr, ldb_, tsB_, K_, M_, N_, Z_, zdiv_, zA1_, zA2_, zB1_, zB2_, cid_) do { \
    pg8::Gemm g_{(const bf16_t*)(Aptr), (const bf16_t*)(Bptr), (lda_), (ldb_), (K_), (zdiv_), (long)(zA1_), (long)(zA2_), (long)(zB1_), (long)(zB2_), (long)256 * (lda_), (long)(tsB_)}; \
    pg8::Order S_; S_.init((M_), (N_), (Z_), G_, (cid_)); \
    pg8::gemm_phase<EpiT, (MK_ALIGN != 0)>(F.lds, g_, S_, Eobj); } while (0)

__global__ void __launch_bounds__(NTHR, 2) mk_fwd(Args args) {
    extern __shared__ __attribute__((aligned(16))) unsigned char lds_raw[];
    Frame F;
    F.lds = (LAS unsigned char*)lds_raw;
    const int tid0 = threadIdx.x;
    volatile LAS unsigned* MISC = (volatile LAS unsigned*)(F.lds + MISC_OFF);
    for (int u = tid0; u < (LDS_BYTES - RING_BYTES) / 4; u += NTHR) ((LAS unsigned*)(F.lds + RING_BYTES))[u] = 0u;
    __syncthreads();
    if (args.ph_hi - args.ph_lo > 1) (void)xcd_barrier_post((unsigned*)(args.ws + WS_CTL) + CW_BAR, MISC + 8);
#define IN(k) (KA->ph_lo <= (k) && (k) < KA->ph_hi)
#define SEAM(k) do { KA_LOAD(); if (KA->ph_lo <= (k) && (k) + 1 < KA->ph_hi) { XcdBarrier bar_; bar_.bar = WSP(unsigned, WS_CTL) + CW_BAR; bar_.x = xb_xcc_id(); bar_.st = (volatile LAS unsigned*)(F.lds + MISC_OFF) + 8; xcd_barrier(bar_); } } while (0)
#ifndef MK_DUP
#define MK_DUP 0
#endif
#ifndef MK_DUP_LATONLY
#define MK_DUP_LATONLY 0
#endif
#ifndef MK_PROBE_SUB
#define MK_PROBE_SUB 0
#endif
#ifndef MK_PROBE_K
#define MK_PROBE_K DFF
#endif
#ifndef MK_PROBE_TS0
#define MK_PROBE_TS0 0
#endif
#ifndef MK_PROBE_NULLEPI
#define MK_PROBE_NULLEPI 0
#endif
#ifndef MK_FUSED_NORM
#define MK_FUSED_NORM 0
#endif
#ifndef MK_PROBE_COLDW
#define MK_PROBE_COLDW 0
#endif
#ifndef MK_ALIGN
#define MK_ALIGN 1
#endif
#ifndef MK_DUPN
#define MK_DUPN 2
#endif
#define NREP(bit) (1 + (((MK_DUP) >> (bit)) & 1) * (MK_DUPN - 1))
#define REP(bit) for (int rep_ = 0; rep_ < NREP(bit); ++rep_)
#define SEAMR(k, bit) do { KA_LOAD(); if (KA->ph_lo <= (k) && ((k) + 1 < KA->ph_hi || rep_ + 1 < NREP(bit))) { XcdBarrier bar_; bar_.bar = WSP(unsigned, WS_CTL) + CW_BAR; bar_.x = xb_xcc_id(); bar_.st = (volatile LAS unsigned*)(F.lds + MISC_OFF) + 8; xcd_barrier(bar_); } } while (0)
#define XR_ WSP(float, WS_XR)
#define MODL_ (WSP(float, WS_MOD) + (size_t)layer * 3 * NMOD)
#define NORMG_ (KA->in[6] + layer * 3 * D)
#define CID_ ((int)blockIdx.x)
#define CIDR_ ((int)gridDim.x - 1 - (int)blockIdx.x)
#define G_ ((int)gridDim.x)

    REP(0) {
    { KA_LOAD(); if (IN(0)) { ph_mod(F); __syncthreads(); ph_weights(F); ph_tables(F); } }
    SEAMR(0, 0); }

#ifdef MK_PROBE_BAR
    for (int eb = 0; eb < MK_PROBE_BAR; ++eb) { KA_LOAD(); XcdBarrier bar_; bar_.bar = WSP(unsigned, WS_CTL) + CW_BAR; bar_.x = xb_xcc_id(); bar_.st = (volatile LAS unsigned*)(F.lds + MISC_OFF) + 8; xcd_barrier(bar_); }
#endif
    for (int layer = 0; layer < 4; ++layer) {
        const int pb = 1 + layer * PPL, j = layer >> 1;
        const bool even = (layer & 1) == 0, use_ctx = layer <= 2, ctx_out = layer < 2;
        const int rows_n = use_ctx ? MT : ML, rows_m = ctx_out ? MT : ML;
        const bool fusedn = MK_FUSED_NORM && (int)gridDim.x == 256;
        if (!(fusedn && layer > 0 && rows_n == ML))
        REP(1) {
        { KA_LOAD(); if (IN(pb + 0)) { KA_LOAD(); ph_norm(F, NORMG_, MODL_, 0, (fusedn && layer > 0) ? ML : 0, rows_n, (rep_ + 1 < NREP(1)) ? 0 : ((layer == 1 || layer == 2) ? 11 : 0), layer == 0 ? KA->in[0] : XR_, layer == 0 ? KA->in[2] : XR_ + (size_t)ML * D); } }
        SEAMR(pb + 0, 1); }
        REP(2) {
        { KA_LOAD(); if (IN(pb + 1)) { KA_LOAD(); EpiSwiglu E{WSP(bf16_t, WS_H)};
            if (MK_PROBE_NULLEPI && rep_ + 1 < NREP(2)) { EpiNull En; MK_GEMM(EpiNull, En, WSP(bf16_t, WS_XN), D, WSP(bf16_t, WS_W13) + (size_t)(layer * 2) * 2 * DFF * D, D, D, rows_n, 2 * DFF, 1, 1, 0, 0, 0, 0, CID_); }
            else MK_GEMM(EpiSwiglu, E, WSP(bf16_t, WS_XN), D, WSP(bf16_t, WS_W13) + (size_t)(layer * 2 + ((MK_PROBE_COLDW && rep_ + 1 < NREP(2)) ? ((layer + 2) % 4) * 2 - layer * 2 + 1 : 0)) * 2 * DFF * D, D, D, rows_n, 2 * DFF, 1, 1, 0, 0, 0, 0, CID_); } }
        SEAMR(pb + 1, 2); }
        REP(14) { const float gsm_ = (rep_ + 1 < NREP(14)) ? 0.f : 1.f;
        { KA_LOAD(); if (IN(pb + 2)) {
            if (use_ctx && (!MK_DUP_LATONLY || gsm_ != 0.f)) { KA_LOAD(); EpiPart E{WSP(float, WS_PART), MODL_ + 2 * D, 0.5f * gsm_};
              MK_GEMM(EpiPart, E, WSP(bf16_t, WS_H) + (size_t)ML * HP, HP, WSP(bf16_t, WS_W2) + (size_t)(layer * 2) * D * HP, HP, 512, MC, D, 11, 1, 512, 0, 512, 0, CIDR_); }
                        { KA_LOAD(); EpiResid<false> E{layer == 0 ? KA->in[0] : XR_, XR_, MODL_ + 2 * D, 0.5f * gsm_, 0, fusedn ? 1 : 0};
              if (MK_PROBE_TS0 && gsm_ == 0.f) { pg8::Gemm g_{MK_PROBE_TS0 == 2 ? WSP(bf16_t, WS_CTL + 262144) : WSP(bf16_t, WS_H), MK_PROBE_TS0 == 2 ? WSP(bf16_t, WS_CTL + 262144) : WSP(bf16_t, WS_W2) + (size_t)(layer * 2) * D * HP, MK_PROBE_TS0 == 2 ? 0 : HP, MK_PROBE_TS0 == 2 ? 0 : HP, MK_PROBE_K, 1, 0, 0, 0, 0, 0, 0}; pg8::Order S_; S_.init(ML, D, 1, G_, CID_); pg8::gemm_phase<EpiResid<false>, true>(F.lds, g_, S_, E); }
              else MK_GEMM(EpiResid<false>, E, WSP(bf16_t, WS_H), HP, WSP(bf16_t, WS_W2) + (size_t)(layer * 2) * D * HP, HP, (gsm_ == 0.f ? MK_PROBE_K : DFF), ML, D, 1, 1, 0, 0, 0, 0, CID_); }
            if (fusedn && gsm_ != 0.f) { KA_LOAD(); panel_publish(KA, layer * 3 + 1); }

            if (fusedn && gsm_ != 0.f) { KA_LOAD(); panel_norm(F, layer * 3 + 1, NORMG_ + D, MODL_, 3); }
        } }
        SEAMR(pb + 2, 14); }
        if (!(fusedn && rows_n == ML))
        REP(3) {
        { KA_LOAD(); if (IN(pb + 3)) { KA_LOAD(); ph_norm(F, NORMG_ + D, MODL_, 3, fusedn ? ML : 0, rows_n, (rep_ + 1 < NREP(3)) ? 0 : (use_ctx ? 11 : 0), XR_, layer == 0 ? KA->in[2] : XR_ + (size_t)ML * D); } }
        SEAMR(pb + 3, 3); }
        if (even) {
            REP(4) {
            { KA_LOAD(); if (IN(pb + 4)) { { KA_LOAD(); EpiStoreBf16 E{WSP(bf16_t, WS_PROJ), NPJ, 1.0f, 0};
                MK_GEMM(EpiStoreBf16, E, WSP(bf16_t, WS_XN), D, WSP(bf16_t, WS_WIN) + (size_t)j * NPJ * D, D, D, MT, NPJ, 1, 1, 0, 0, 0, 0, CID_); }
                } }
            SEAMR(pb + 4, 4); }
            REP(5) {
            { KA_LOAD(); if (IN(pb + 5)) { const int sub_ = (rep_ + 1 < NREP(5)) ? MK_PROBE_SUB : 0; if (sub_ == 0 || sub_ == 1) ph_dt(F, j); if (sub_ == 0 || sub_ == 2) ph_qknorm(F, j); if (sub_ == 0 || sub_ == 3) ph_conv2(F, j); if (sub_ == 0 || sub_ == 4) ph_vt(F); } }
            SEAMR(pb + 5, 5); }
            REP(6) {
            { KA_LOAD(); if (IN(pb + 6)) { ph_ssd1_attn(F, j, ctx_out ? 1 : 0, (rep_ + 1 < NREP(6)) ? MK_PROBE_SUB : 0); } }
            SEAMR(pb + 6, 6); }
            REP(7) {
            { KA_LOAD(); if (IN(pb + 7)) ph_scan(F); }
            SEAMR(pb + 7, 7); }
            REP(8) {
            { KA_LOAD(); if (IN(pb + 8)) ph_ssd3(F, j, ctx_out ? 0 : 2); }
            SEAMR(pb + 8, 8); }
            REP(9) {
            { KA_LOAD(); if (IN(pb + 9)) ph_gated(F, j, rows_m); }
            SEAMR(pb + 9, 9); }
        } else {
            REP(10) {
            { KA_LOAD(); if (IN(pb + 4)) {
                { KA_LOAD(); EpiF1b E{WSP(bf16_t, WS_BT2)};
                  MK_GEMM_TS(EpiF1b, E, WSP(bf16_t, WS_DFTC), 512, WSP(bf16_t, WS_XN), 16 * D, D, 512, 1024, SEQ, 8, 4, 0, 0, (long)SEQ * D, 512, CID_); }
                if (ctx_out) { KA_LOAD(); EpiF1 E{WSP(bf16_t, WS_BT2C), CTXL};
                  MK_GEMM(EpiF1, E, WSP(bf16_t, WS_DFTC), 512, WSP(bf16_t, WS_XN) + (size_t)ML * D, D, 512, 1024, CTXL, 8, 4, 0, 0, (long)CTXL * D, 512, CIDR_); }
            } }
            SEAMR(pb + 4, 10); }
            REP(11) {
            { KA_LOAD(); if (IN(pb + 5)) {
                { KA_LOAD(); EpiTw E{WSP(bf16_t, WS_TW)};
                  MK_GEMM(EpiTw, E, WSP(bf16_t, WS_F1MAT), 512, WSP(bf16_t, WS_BT2), 512, 512, 512, 16 * D, 2, 1, 0, 0, (long)D * 8192, 0, CID_); }
                if (ctx_out) { KA_LOAD(); EpiStoreBf16 E{WSP(bf16_t, WS_MIX) + (size_t)ML * D, D, 1.0f / sqrtf(256.f * 512.f), (long)CTXL * D};
                  MK_GEMM(EpiStoreBf16, E, WSP(bf16_t, WS_DFT256), 512, WSP(bf16_t, WS_BT2C), 512, 512, CTXL, D, 2, 1, 0, 0, (long)D * 512, 0, CIDR_); }
            } }
            SEAMR(pb + 5, 11); }
            REP(17) {
            { KA_LOAD(); if (IN(pb + 6)) {
                KA_LOAD(); EpiFS2 E{WSP(bf16_t, WS_MIX), 1.0f / sqrtf(4096.f * 512.f)};
                MK_GEMM(EpiFS2, E, WSP(bf16_t, WS_F2MAT), 512, WSP(bf16_t, WS_TW), 8192, 512, 256, D, 32, 16, 0, 0, (long)D * 8192, 512, CID_);
            } }
            SEAMR(pb + 6, 17); }
        }
        REP(15) { const float gsm_ = (rep_ + 1 < NREP(15)) ? 0.f : 1.f;
        { KA_LOAD(); if (IN(pb + 10)) {
            if (ctx_out) { KA_LOAD(); const bf16_t* Wm = even ? WSP(bf16_t, WS_WOUT) + (size_t)j * D * D : WSP(bf16_t, WS_WF) + (size_t)j * D * D;
              EpiPart E{WSP(float, WS_PART), MODL_ + 5 * D, 1.0f * gsm_};
              MK_GEMM(EpiPart, E, WSP(bf16_t, WS_MIX) + (size_t)ML * D, D, Wm, D, 512, MC, D, 4, 1, 512, 0, 512, 0, CIDR_); }
                        { KA_LOAD(); const bf16_t* Wm = even ? WSP(bf16_t, WS_WOUT) + (size_t)j * D * D : WSP(bf16_t, WS_WF) + (size_t)j * D * D;
              EpiResid<false> E{XR_, XR_, MODL_ + 5 * D, 1.0f * gsm_, 0, fusedn ? 1 : 0};
              MK_GEMM(EpiResid<false>, E, WSP(bf16_t, WS_MIX), D, Wm, D, D, ML, D, 1, 1, 0, 0, 0, 0, CID_); }
            if (fusedn && gsm_ != 0.f) { KA_LOAD(); panel_publish(KA, layer * 3 + 2); }

            if (fusedn && gsm_ != 0.f) { KA_LOAD(); panel_norm(F, layer * 3 + 2, NORMG_ + 2 * D, MODL_, 6); }
        } }
        SEAMR(pb + 10, 15); }
        if (!(fusedn && rows_m == ML))
        REP(12) {
        { KA_LOAD(); if (IN(pb + 11)) { KA_LOAD(); ph_norm(F, NORMG_ + 2 * D, MODL_, 6, fusedn ? ML : 0, rows_m, (rep_ + 1 < NREP(12)) ? 0 : (ctx_out ? 4 : 0), XR_, XR_ + (size_t)ML * D); } }
        SEAMR(pb + 11, 12); }
        REP(13) {
        { KA_LOAD(); if (IN(pb + 12)) { KA_LOAD(); EpiSwiglu E{WSP(bf16_t, WS_H)};
            MK_GEMM(EpiSwiglu, E, WSP(bf16_t, WS_XN), D, WSP(bf16_t, WS_W13) + (size_t)(layer * 2 + 1) * 2 * DFF * D, D, D, rows_m, 2 * DFF, 1, 1, 0, 0, 0, 0, CID_); } }
        SEAMR(pb + 12, 13); }
        REP(16) { const float gsm_ = (rep_ + 1 < NREP(16)) ? 0.f : 1.f;
        { KA_LOAD(); if (IN(pb + 13)) {
            if (ctx_out && (!MK_DUP_LATONLY || gsm_ != 0.f)) { KA_LOAD(); EpiPart E{WSP(float, WS_PART), MODL_ + 8 * D, 0.5f * gsm_};
              MK_GEMM(EpiPart, E, WSP(bf16_t, WS_H) + (size_t)ML * HP, HP, WSP(bf16_t, WS_W2) + (size_t)(layer * 2 + 1) * D * HP, HP, 512, MC, D, 11, 1, 512, 0, 512, 0, CIDR_); }
                        { KA_LOAD(); float* xo = layer == 3 ? KA->out : XR_;
              EpiResid<false> E{XR_, xo, MODL_ + 8 * D, 0.5f * gsm_, 0, (fusedn && layer < 3) ? 1 : 0};
              if (MK_PROBE_TS0 && gsm_ == 0.f) { pg8::Gemm g_{MK_PROBE_TS0 == 2 ? WSP(bf16_t, WS_CTL + 262144) : WSP(bf16_t, WS_H), MK_PROBE_TS0 == 2 ? WSP(bf16_t, WS_CTL + 262144) : WSP(bf16_t, WS_W2) + (size_t)(layer * 2 + 1) * D * HP, MK_PROBE_TS0 == 2 ? 0 : HP, MK_PROBE_TS0 == 2 ? 0 : HP, MK_PROBE_K, 1, 0, 0, 0, 0, 0, 0}; pg8::Order S_; S_.init(ML, D, 1, G_, CID_); pg8::gemm_phase<EpiResid<false>, true>(F.lds, g_, S_, E); }
              else MK_GEMM(EpiResid<false>, E, WSP(bf16_t, WS_H), HP, WSP(bf16_t, WS_W2) + (size_t)(layer * 2 + 1) * D * HP, HP, (gsm_ == 0.f ? MK_PROBE_K : DFF), ML, D, 1, 1, 0, 0, 0, 0, CID_); }
            if (fusedn && layer < 3 && gsm_ != 0.f) { KA_LOAD(); panel_publish(KA, (layer + 1) * 3 + 0); }

            if (fusedn && layer < 3 && gsm_ != 0.f) { KA_LOAD(); panel_norm(F, (layer + 1) * 3 + 0, KA->in[6] + (layer + 1) * 3 * D, WSP(float, WS_MOD) + (size_t)(layer + 1) * 3 * NMOD, 0); }
        } }
        SEAMR(pb + 13, 16); }
    }
#undef IN
#undef SEAM
}
}

#ifndef MK_DUMP_OFF
#define MK_DUMP_OFF mk::WS_XR
#endif
#ifndef MK_PER_PHASE
#define MK_PER_PHASE 0
#endif
extern "C" void kernel_launch(void* const* d_in, const int* in_sizes, int n_in, void* d_out, int out_size, void* d_ws, size_t ws_size, hipStream_t stream) {
    static int grid = 0;
    if (grid == 0) {
        if (n_in != 21 || ws_size < mk::WS_END) { fprintf(stderr, "kernel_launch: unexpected n_in %d / ws %zu (need %zu)\n", n_in, ws_size, (size_t)mk::WS_END); grid = -1; return; }
        int dev = 0, cus = 0, per_cu = 0;
        if (hipGetDevice(&dev) != hipSuccess || hipDeviceGetAttribute(&cus, hipDeviceAttributeMultiprocessorCount, dev) != hipSuccess) { grid = -1; return; }
        if (hipFuncSetAttribute((const void*)mk::mk_fwd, hipFuncAttributeMaxDynamicSharedMemorySize, mk::LDS_BYTES) != hipSuccess) { fprintf(stderr, "kernel_launch: hipFuncSetAttribute failed\n"); grid = -1; return; }
        if (hipOccupancyMaxActiveBlocksPerMultiprocessor(&per_cu, (const void*)mk::mk_fwd, mk::NTHR, mk::LDS_BYTES) != hipSuccess || per_cu < 1) fprintf(stderr, "kernel_launch: occupancy query says %d\n", per_cu);
        (void)hipGetLastError();
        grid = cus;
    }
    if (grid < 0) return;
#ifdef MK_DBG_POISON
    (void)hipMemsetAsync((char*)d_ws, 0xAA, mk::WS_END, stream);
#endif
    (void)hipMemsetAsync((char*)d_ws + mk::WS_CTL, 0, mk::CTL_ZERO_BYTES, stream);
    mk::Args a{};
    for (int i = 0; i < 21; ++i) a.in[i] = (const float*)d_in[i];
    a.out = (float*)d_out; a.ws = (unsigned char*)d_ws;
#if MK_PER_PHASE
    for (int k = 0; k < mk::N_PHASES; ++k) {
        const int loc = (k - 1) % mk::PPL, layer = (k - 1) / mk::PPL;
        if (k > 0 && (layer & 1) && (loc >= 7 && loc <= 9)) continue;
        a.ph_lo = k; a.ph_hi = k + 1;
        hipLaunchKernelGGL(mk::mk_fwd, dim3(grid), dim3(mk::NTHR), mk::LDS_BYTES, stream, a);
#ifdef MK_STOP_AFTER
        if (k == MK_STOP_AFTER) { (void)hipMemcpyAsync(d_out, (char*)d_ws + MK_DUMP_OFF, (size_t)mk::ML * mk::D * 4, hipMemcpyDeviceToDevice, stream); break; }
#endif
    }
#else
    a.ph_lo = 0; a.ph_hi = mk::N_PHASES;
    hipLaunchKernelGGL(mk::mk_fwd, dim3(grid), dim3(mk::NTHR), mk::LDS_BYTES, stream, a);
#endif
}
```

```cpp
#define MK_F8_MASK 15
#include <hip/hip_runtime.h>
#include <stdint.h>
#include <cstdio>
namespace pg8 {
#define PG8_LAS __attribute__((address_space(3)))
typedef unsigned short bf16_t;
typedef short bf16x8 __attribute__((ext_vector_type(8)));
typedef float f32x4 __attribute__((ext_vector_type(4)));
typedef float f32x2 __attribute__((ext_vector_type(2)));
typedef unsigned u32x4 __attribute__((ext_vector_type(4)));
typedef unsigned u32x2 __attribute__((ext_vector_type(2)));
constexpr int BM = 256, BK = 64, HALF = 128, HTB = HALF * BK * 2  , STAGE_BYTES = 8 * HTB, NXCD = 8, WGM = 8;

__host__ __device__ __forceinline__ int lds_byte(int r, int c) { const int st = (r >> 4) * 2 + (c >> 5), rr = r & 15, cc = c & 31, ob = rr * 64 + cc * 2; return st * 1024 + (ob ^ (((ob >> 9) & 1) << 5)); }
__host__ __device__ __forceinline__ void stage_rc(int b, int& R, int& C) { const int st = b / 1024, sb = b % 1024, swz = sb ^ (((sb >> 9) & 1) << 5); R = (st >> 1) * 16 + swz / 64; C = (st & 1) * 32 + (swz % 64) / 2; }
__host__ __device__ __forceinline__ int perm32(int rho) { const int n = rho >> 4, i = rho & 15; return 8 * (i >> 2) + 4 * n + (i & 3); }

struct Unit { int pm, pn, pz; };
struct Gemm { const bf16_t* A; const bf16_t* Bt; int lda, ldb, K, zdiv; long zA1, zA2, zB1, zB2; long tsA, tsB; int sclB, sclA; };

struct Order {
    int nM, nN, per, total, G, c;
    __host__ __device__ void init(int M, int N, int Z, int G_, int c_) { nM = M / BM; nN = N / BM; per = nM * nN; total = per * Z; G = G_; c = c_; }
    __host__ __device__ bool next(int i, Unit& u) const {
        const long L = (long)i * G + c; if (L >= total) return false;
        const int z = (int)(L / per); int wgid = (int)(L % per); { const int q = per / NXCD, r = per % NXCD, xcd = wgid % NXCD, off = wgid / NXCD; wgid = (xcd < r ? xcd * (q + 1) : r * (q + 1) + (xcd - r) * q) + off; }
        const int nig = WGM * nN, gid = wgid / nig, fm = gid * WGM, gsz = (nM - fm) < WGM ? (nM - fm) : WGM;
        u.pm = fm + ((wgid % nig) % gsz); u.pn = (wgid % nig) / gsz; u.pz = z; return true;
    }
};

typedef __bf16 bf16x2_t __attribute__((ext_vector_type(2)));
__device__ __forceinline__ unsigned cvt_pk_bf16(float lo, float hi) { const f32x2 v = {lo, hi}; const bf16x2_t b = __builtin_convertvector(v, bf16x2_t); return __builtin_bit_cast(unsigned, b); }

typedef int v8i32 __attribute__((ext_vector_type(8)));
template <class Epi, bool ALIGN_EPI = true, bool F8 = false>
__device__ __forceinline__ void gemm_phase(PG8_LAS unsigned char* lds, const Gemm g, const Order& S, const Epi& E) {
    int tz_ = threadIdx.x; asm volatile("" : "+v"(tz_));
    const int tid = tz_, wid = __builtin_amdgcn_readfirstlane(tid >> 6), lane = tid & 63, wr = wid >> 2, wc = wid & 3, fr = lane & 15, fq = lane >> 4;
    const int K = g.K, nt = K / BK;
    unsigned voffA[2], voffB[2];
#pragma unroll
    for (int i = 0; i < 2; ++i) { int R, C; stage_rc(tid * 16 + i * 8192, R, C); const int Rb = Epi::PERM ? ((R & ~31) + perm32(R & 31)) : R;
        voffA[i] = (unsigned)(R * g.lda + C) * 2u; voffB[i] = (unsigned)(Rb * g.ldb + C) * 2u; }
    const size_t kstep = (size_t)(BK * 2);
    const size_t hstepA = (size_t)HALF * g.lda * 2, hstepB = (size_t)HALF * g.ldb * 2;
    const unsigned ldsw = (unsigned)wid * 1024u;
    const int aoff = lds_byte(wr * 64 + fr, fq * 8), boff = lds_byte(wc * 32 + fr, fq * 8);
#define PG8_SA(b, h) (((b) * 2 + (h)) * HTB)
#define PG8_SB(b, h) ((4 + (b) * 2 + (h)) * HTB)
#ifndef PG8_AUX_A
#define PG8_AUX_A 0
#endif
#ifndef PG8_AUX_B
#define PG8_AUX_B 0
#endif
#define PG8_STAGE(bufoff, gbase, voff) do { _Pragma("unroll") for (int _i = 0; _i < 2; ++_i) \
        __builtin_amdgcn_global_load_lds((const unsigned*)((const char*)(gbase) + (voff)[_i]), (PG8_LAS unsigned*)(lds + (bufoff) + ldsw + _i * 8192), 16, 0, ((bufoff) >= 4 * HTB ? PG8_AUX_B : PG8_AUX_A)); } while (0)
#define PG8_LDA(dst, b, h) do { _Pragma("unroll") for (int m = 0; m < 4; ++m) _Pragma("unroll") for (int k = 0; k < 2; ++k) dst[m][k] = *(const PG8_LAS bf16x8*)(lds + PG8_SA(b, h) + aoff + m * 2048 + k * 1024); } while (0)
#define PG8_LDB(dst, b, h) do { _Pragma("unroll") for (int n = 0; n < 2; ++n) _Pragma("unroll") for (int k = 0; k < 2; ++k) dst[n][k] = *(const PG8_LAS bf16x8*)(lds + PG8_SB(b, h) + boff + n * 2048 + k * 1024); } while (0)
#define PG8_CAT(x0, x1) __builtin_shufflevector(__builtin_bit_cast(u32x4, x0), __builtin_bit_cast(u32x4, x1), 0, 1, 2, 3, 4, 5, 6, 7)
#define PG8_MMA(ai, bj, At, Bt) do { __builtin_amdgcn_s_setprio(1); _Pragma("unroll") for (int m = 0; m < 4; ++m) _Pragma("unroll") for (int n = 0; n < 2; ++n) { \
        if constexpr (F8) asm volatile("v_mfma_f32_16x16x128_f8f6f4 %0, %1, %2, %0" : "+v"(acc[ai][bj][m][n]) : "v"(__builtin_bit_cast(v8i32, PG8_CAT(Bt[n][0], Bt[n][1]))), "v"(__builtin_bit_cast(v8i32, PG8_CAT(At[m][0], At[m][1])))); \
        else { _Pragma("unroll") for (int k = 0; k < 2; ++k) acc[ai][bj][m][n] = __builtin_amdgcn_mfma_f32_16x16x32_bf16(Bt[n][k], At[m][k], acc[ai][bj][m][n], 0, 0, 0); } } \
        __builtin_amdgcn_s_setprio(0); } while (0)
#define PG8_WAIT_V(n) asm volatile("s_waitcnt vmcnt(" #n ")" ::: "memory")
#define PG8_WAIT_L(n) asm volatile("s_waitcnt lgkmcnt(" #n ")" ::: "memory")
#define PG8_BAR __builtin_amdgcn_s_barrier()
#define PG8_SCHED __builtin_amdgcn_sched_barrier(0)
#define PG8_BASEA(u) ((const char*)g.A + ((size_t)(u).pm * g.tsA + (size_t)((u).pz / g.zdiv) * g.zA1 + (size_t)((u).pz % g.zdiv) * g.zA2) * 2)
#define PG8_BASEB(u) ((const char*)g.Bt + ((size_t)(u).pn * g.tsB + (size_t)((u).pz / g.zdiv) * g.zB1 + (size_t)((u).pz % g.zdiv) * g.zB2) * 2)
    Unit cur, nxt; int ui = 0;
    if (!S.next(0, cur)) return;
    f32x4 acc[2][2][4][2];
#pragma unroll
    for (int a = 0; a < 2; ++a)
#pragma unroll
        for (int b = 0; b < 2; ++b)
#pragma unroll
            for (int m = 0; m < 4; ++m)
#pragma unroll
                for (int n = 0; n < 2; ++n) acc[a][b][m][n] = (f32x4){0.f, 0.f, 0.f, 0.f};
    bf16x8 At[4][2], B0[2][2], B1[2][2];
    const char* cA = PG8_BASEA(cur); const char* cB = PG8_BASEB(cur);
    PG8_STAGE(PG8_SB(0, 0), cB, voffB); PG8_STAGE(PG8_SB(0, 1), cB + hstepB, voffB); PG8_STAGE(PG8_SA(0, 0), cA, voffA); PG8_STAGE(PG8_SA(0, 1), cA + hstepA, voffA);
    if (wr == 1) PG8_BAR;
    PG8_WAIT_V(2); PG8_BAR;
    PG8_STAGE(PG8_SB(1, 0), cB + kstep, voffB); PG8_STAGE(PG8_SA(1, 0), cA + kstep, voffA); PG8_STAGE(PG8_SB(1, 1), cB + hstepB + kstep, voffB);
    PG8_WAIT_V(6); PG8_BAR;
    for (;;) {
        const bool has_next = S.next(ui + 1, nxt);
        const char* nA = has_next ? PG8_BASEA(nxt) : cA; const char* nB = has_next ? PG8_BASEB(nxt) : cB;
        for (int t = 0; t < nt; t += 2) {
            const bool last = (t == nt - 2);
            const char* a1 = cA + (size_t)(t + 1) * kstep;
            const char* a2 = last ? nA : cA + (size_t)(t + 2) * kstep; const char* b2 = last ? nB : cB + (size_t)(t + 2) * kstep;
            const char* a3 = a2 + kstep; const char* b3 = b2 + kstep;
            PG8_LDB(B0, 0, 0); PG8_LDB(B1, 0, 1); PG8_SCHED; PG8_LDA(At, 0, 0); PG8_STAGE(PG8_SA(1, 1), a1 + hstepA, voffA);
            PG8_WAIT_V(8); PG8_WAIT_L(0); PG8_BAR; PG8_MMA(0, 0, At, B0); PG8_MMA(0, 1, At, B1); PG8_BAR; PG8_SCHED;
            PG8_LDA(At, 0, 1); PG8_STAGE(PG8_SB(0, 0), b2, voffB); PG8_STAGE(PG8_SB(0, 1), b2 + hstepB, voffB); PG8_STAGE(PG8_SA(0, 0), a2, voffA);
            PG8_WAIT_V(8); PG8_WAIT_L(0); PG8_BAR; PG8_MMA(1, 0, At, B0); PG8_MMA(1, 1, At, B1); PG8_BAR; PG8_SCHED;
            PG8_LDB(B0, 1, 0); PG8_LDB(B1, 1, 1); PG8_SCHED; PG8_LDA(At, 1, 0); PG8_STAGE(PG8_SA(0, 1), a2 + hstepA, voffA);
            PG8_WAIT_V(8); PG8_WAIT_L(0); PG8_BAR; PG8_MMA(0, 0, At, B0); PG8_MMA(0, 1, At, B1); PG8_BAR; PG8_SCHED;
            PG8_LDA(At, 1, 1); PG8_STAGE(PG8_SB(1, 0), b3, voffB); PG8_STAGE(PG8_SB(1, 1), b3 + hstepB, voffB); PG8_STAGE(PG8_SA(1, 0), a3, voffA);
            PG8_WAIT_V(8); PG8_WAIT_L(0); PG8_BAR; PG8_MMA(1, 0, At, B0); PG8_MMA(1, 1, At, B1); PG8_BAR; PG8_SCHED;
        }
        if constexpr (ALIGN_EPI) { if (wr == 0) PG8_BAR; }
        if constexpr (F8) {
            asm volatile("s_nop 15\n\ts_nop 15\n\ts_nop 15\n\ts_nop 15\n\ts_nop 15" ::: "memory");
            const float os_ = __builtin_bit_cast(float, (unsigned)(g.sclA + g.sclB - 127) << 23);
#pragma unroll
            for (int a = 0; a < 2; ++a)
#pragma unroll
                for (int b = 0; b < 2; ++b)
#pragma unroll
                    for (int m = 0; m < 4; ++m)
#pragma unroll
                        for (int n = 0; n < 2; ++n) acc[a][b][m][n] *= os_;
        }
        E(acc, cur, wr, wc, fr, fq);
        if (!has_next) break;
#pragma unroll
        for (int a = 0; a < 2; ++a)
#pragma unroll
            for (int b = 0; b < 2; ++b)
#pragma unroll
                for (int m = 0; m < 4; ++m)
#pragma unroll
                    for (int n = 0; n < 2; ++n) acc[a][b][m][n] = (f32x4){0.f, 0.f, 0.f, 0.f};
        cur = nxt; cA = nA; cB = nB; ++ui;
        if constexpr (ALIGN_EPI) { if (wr == 1) PG8_BAR; }
    }
    PG8_WAIT_V(0);
    if constexpr (!ALIGN_EPI) { if (wr == 0) PG8_BAR; }
    PG8_BAR;
#undef PG8_SA
#undef PG8_SB
#undef PG8_STAGE
#undef PG8_LDA
#undef PG8_LDB
#undef PG8_MMA
#undef PG8_CAT
#undef PG8_WAIT_V
#undef PG8_WAIT_L
#undef PG8_BAR
#undef PG8_SCHED
#undef PG8_BASEA
#undef PG8_BASEB
}
}

namespace mk {
using pg8::bf16_t; using pg8::bf16x8; using pg8::f32x4; using pg8::f32x2; using pg8::u32x4; using pg8::u32x2; using pg8::cvt_pk_bf16;
#define LAS __attribute__((address_space(3)))
constexpr int NWAVES = 8, NTHR = 512;
constexpr int D = 2048, SEQ = 4096, CTXL = 256, ML = 8192, MC = 512, MT = 8704, DFF = 5632, NMOD = 18432, INW = 5664, NPJ = 5632;
#ifndef MK_HP
#define MK_HP 5632
#endif
constexpr int HP = MK_HP;
#ifndef MK_NT_X
#define MK_NT_X 0
#endif
#ifndef MK_F8_MASK
#define MK_F8_MASK 0
#endif
constexpr int F8_SA = 3, F8_SW = 6;
#ifndef MK_NT_PST
#define MK_NT_PST 0
#endif
#ifndef MK_NT_PRO
#define MK_NT_PRO 1
#endif
constexpr float EPS = 1e-6f;
constexpr float LOG2E = 1.4426950408889634f;

constexpr size_t al256(size_t x) { return (x + 255) / 256 * 256; }
constexpr size_t WS_CTL = 0, CTL_ZERO_BYTES = 1u << 20;
constexpr size_t WS_MOD = WS_CTL + CTL_ZERO_BYTES;
constexpr size_t WS_ROPE = WS_MOD + al256((size_t)4 * 3 * NMOD * 4);
constexpr size_t WS_XR = WS_ROPE + al256(64 * 32 * 8);
constexpr size_t WS_XN = WS_XR + al256((size_t)MT * D * 4);
constexpr size_t WS_H = WS_XN + al256((size_t)MT * D * 2);
constexpr size_t WS_PROJ = WS_H + al256((size_t)MT * HP * 2);
constexpr size_t WS_QP = WS_PROJ + al256((size_t)MT * NPJ * 2);
constexpr size_t WS_QR = WS_QP + al256((size_t)MT * 1024 * 2);
constexpr size_t WS_KR = WS_QR + al256((size_t)MT * 1024 * 2);
constexpr size_t WS_XBC = WS_KR + al256((size_t)MT * (1024 + 64) * 2);
constexpr size_t WS_DT = WS_XBC + al256((size_t)MT * 1536 * 2);
constexpr size_t WS_DA = WS_DT + al256((size_t)MT * 32 * 4);
constexpr size_t WS_YF = WS_DA + al256((size_t)MT * 32 * 4);
constexpr size_t WS_YB = WS_YF + al256((size_t)MT * 1024 * 4);
constexpr size_t WS_MIX = WS_YB + al256((size_t)MT * 1024 * 4);
constexpr size_t WS_W13 = WS_MIX + al256((size_t)MT * D * 2);
constexpr size_t WS_W2 = WS_W13 + al256((size_t)8 * 2 * DFF * D * 2);
constexpr size_t WS_WIN = WS_W2 + al256((size_t)8 * D * HP * 2);
constexpr size_t WS_WDT = WS_WIN + al256((size_t)2 * NPJ * D * 2);
constexpr size_t WS_WOUT = WS_WDT + al256((size_t)2 * 32 * D * 2);
constexpr size_t WS_WF = WS_WOUT + al256((size_t)2 * D * D * 2);
constexpr size_t WS_DFTL = WS_WF + al256((size_t)2 * D * D * 2);
constexpr size_t WS_DFTC = WS_DFTL + al256((size_t)4096 * 8192 * 2);
constexpr size_t WS_DFT256 = WS_DFTC + al256((size_t)1024 * 512 * 2);
constexpr size_t WS_F1MAT = WS_DFT256 + al256((size_t)256 * 512 * 2);
constexpr size_t WS_F2MAT = WS_F1MAT + al256((size_t)512 * 512 * 2);
constexpr size_t WS_BT2 = WS_F2MAT + al256((size_t)256 * 512 * 2);
constexpr size_t WS_BT2C = WS_BT2 + al256((size_t)2 * 2048 * 8192 * 2);
constexpr int NCC = 34, TOKS = NCC * 128, KRP = 1024 + 64, VTP = TOKS + 64;
constexpr size_t WS_XST = WS_BT2C + al256((size_t)2 * 2048 * 512 * 2);
constexpr size_t WS_BMT = WS_XST + al256((size_t)2 * 1024 * TOKS * 2);
constexpr size_t WS_SST = WS_BMT + al256((size_t)2 * 256 * TOKS * 2);
constexpr size_t WS_DEC = WS_SST + al256((size_t)2 * NCC * 2 * 16 * 8192 * 4);
constexpr size_t WS_VT = WS_DEC + al256((size_t)2 * NCC * 32 * 4);
constexpr size_t WS_PART = WS_VT + al256((size_t)2 * 8 * 128 * (TOKS + 64) * 2);
constexpr size_t WS_W28 = WS_PART + al256((size_t)11 * MC * D * 4);
constexpr size_t WS_END = WS_W28 + al256((size_t)8 * D * DFF);
constexpr size_t WS_TW = WS_SST;
constexpr size_t WS_HIN = WS_YB;
constexpr int CW_BAR = 4096, CW_PCNT = 8192, CW_PTMO = 8000;

constexpr int RING_BYTES = 131072, MISC_OFF = RING_BYTES + 320, LDS_BYTES = 147456;

#define XB_TMO      128
#define XB_XCNT(j)  (256  + 64 * (j))
#define XB_XSUB(j)  (1280 + 64 * (j))
#define XB_XGEN(j)  (2304 + 64 * (j))
#define XB_TOP      3328
#define XB_TOPGEN   3392
#define XCD_BAR_WORDS 3456
#define XB_SPIN_CAP (1u << 18)
__device__ __forceinline__ unsigned xb_ld(unsigned* p)              { return __hip_atomic_load(p, __ATOMIC_RELAXED, __HIP_MEMORY_SCOPE_AGENT); }
__device__ __forceinline__ unsigned xb_add(unsigned* p, unsigned v) { return __hip_atomic_fetch_add(p, v, __ATOMIC_RELAXED, __HIP_MEMORY_SCOPE_AGENT); }
__device__ __forceinline__ unsigned xb_xcc_id() { return (unsigned)__builtin_amdgcn_s_getreg((3 << 11) | 20) & 0xFu; }
#define XB_SPIN(cond, bar) do { unsigned _sp = 0; while (cond) { __builtin_amdgcn_s_sleep(1); \
    if ((++_sp & 255u) == 0u) { if (xb_ld(&(bar)[XB_TMO])) break; if (_sp > XB_SPIN_CAP) { atomicAdd(&(bar)[XB_TMO], 1u); break; } } } } while (0)
struct XcdBarrier { unsigned* bar; unsigned x; volatile LAS unsigned* st; };
__device__ __forceinline__ XcdBarrier xcd_barrier_post(unsigned* bar, volatile LAS unsigned* st) {
    XcdBarrier b; b.bar = bar; b.x = xb_xcc_id(); b.st = st;
    if (threadIdx.x == 0) (void)xb_add(&bar[XB_XCNT(b.x)], 1u);
    return b;
}
__device__ __forceinline__ void xcd_barrier_complete(unsigned* bar, unsigned x, unsigned& nloc, unsigned& nx) {
    const unsigned G = gridDim.x * gridDim.y * gridDim.z;
    unsigned sum, cnt, mine, sp = 0u;
    for (;;) {
        sum = 0u; cnt = 0u; mine = 0u;
#pragma unroll
        for (unsigned j = 0; j < 16; ++j) { const unsigned c = xb_ld(&bar[XB_XCNT(j)]); sum += c; cnt += (c > 0u) ? 1u : 0u; mine = (j == x) ? c : mine; }
        if (sum == G) break;
        __builtin_amdgcn_s_sleep(1);
        if ((++sp & 255u) == 0u) { if (xb_ld(&bar[XB_TMO])) break; if (sp > XB_SPIN_CAP) { atomicAdd(&bar[XB_TMO], 1u); break; } }
    }
    nloc = mine > 0u ? mine : 1u; nx = cnt > 0u ? cnt : 1u;
}
__device__ __forceinline__ void xcd_barrier(const XcdBarrier& b) {
    asm volatile("s_waitcnt vmcnt(0)" ::: "memory");
    __syncthreads();
    if (threadIdx.x == 0) {
        unsigned* bar = b.bar;
        __builtin_amdgcn_s_waitcnt(0);
        unsigned nloc = b.st[0], nx = b.st[1];
        if (nloc == 0u) { xcd_barrier_complete(bar, b.x, nloc, nx); b.st[0] = nloc; b.st[1] = nx; }
        const unsigned old = xb_add(&bar[XB_XSUB(b.x)], 1u);
        const unsigned gen = old / nloc;
        if (old + 1u == (gen + 1u) * nloc) {
            __builtin_amdgcn_fence(__ATOMIC_RELEASE, "agent");
            asm volatile("s_waitcnt vmcnt(0)" ::: "memory");
            const unsigned og = xb_add(&bar[XB_TOP], 1u);
            const unsigned tg = og / nx;
            if (og + 1u == (tg + 1u) * nx) xb_add(&bar[XB_TOPGEN], 1u);
            else XB_SPIN(xb_ld(&bar[XB_TOPGEN]) == tg, bar);
            __builtin_amdgcn_fence(__ATOMIC_ACQUIRE, "agent");
            xb_add(&bar[XB_XGEN(b.x)], 1u);
            asm volatile("s_waitcnt vmcnt(0)" ::: "memory");
        } else {
            XB_SPIN(xb_ld(&bar[XB_XGEN(b.x)]) == gen, bar);
            __builtin_amdgcn_fence(__ATOMIC_ACQUIRE, "agent");
            asm volatile("s_waitcnt vmcnt(0)" ::: "memory");
        }
    }
    __syncthreads();
}

__device__ __forceinline__ float shx(float v, int o, int lane) { return __int_as_float(__builtin_amdgcn_ds_bpermute((lane ^ o) << 2, __float_as_int(v))); }
__device__ __forceinline__ float wave_sum(float v, int lane) {
#pragma unroll
    for (int o = 1; o < 64; o <<= 1) v += shx(v, o, lane);
    return v;
}
__device__ __forceinline__ float wave_max(float v, int lane) {
#pragma unroll
    for (int o = 1; o < 64; o <<= 1) v = fmaxf(v, shx(v, o, lane));
    return v;
}
__device__ __forceinline__ float bf2f(unsigned short b) { return __uint_as_float(((unsigned)b) << 16); }
__device__ __forceinline__ float bflo(unsigned w) { return __uint_as_float(w << 16); }
__device__ __forceinline__ float bfhi(unsigned w) { return __uint_as_float(w & 0xffff0000u); }
__device__ __forceinline__ unsigned short f2bf(float f) { return (unsigned short)(cvt_pk_bf16(f, 0.f) & 0xffffu); }
__device__ __forceinline__ float fast_silu(float x) { return x * __builtin_amdgcn_rcpf(1.0f + __builtin_amdgcn_exp2f(-x * LOG2E)); }
__device__ __forceinline__ float silu_acc(float x) { return x / (1.f + expf(-x)); }
__device__ __forceinline__ int panel_v(int P) { return P < 32 ? (P >> 4) : 2; }
__device__ __forceinline__ int row_v(int row) { return row < ML ? (row >> 12) : 2; }

struct EpiSwiglu {
    static constexpr bool PERM = true;
    bf16_t* H;
    __device__ __forceinline__ void operator()(const f32x4 (&acc)[2][2][4][2], const pg8::Unit& u, int wr, int wc, int fr, int fq) const {
        const int row0 = u.pm * 256 + wr * 64 + fr, col0 = u.pn * 128 + wc * 32 + 8 * fq;
#pragma unroll
        for (int ai = 0; ai < 2; ++ai)
#pragma unroll
            for (int m = 0; m < 4; ++m) {
                bf16_t* rowp = H + (size_t)(row0 + ai * 128 + m * 16) * HP + col0;
                const f32x4 a0 = acc[ai][0][m][0], a1 = acc[ai][0][m][1], b0 = acc[ai][1][m][0], b1 = acc[ai][1][m][1];
                u32x4 w;
                w.x = cvt_pk_bf16(fast_silu(a0[0]) * b0[0], fast_silu(a0[1]) * b0[1]); w.y = cvt_pk_bf16(fast_silu(a0[2]) * b0[2], fast_silu(a0[3]) * b0[3]);
                w.z = cvt_pk_bf16(fast_silu(a1[0]) * b1[0], fast_silu(a1[1]) * b1[1]); w.w = cvt_pk_bf16(fast_silu(a1[2]) * b1[2], fast_silu(a1[3]) * b1[3]);
                *(u32x4*)rowp = w;
            }
    }
};
struct EpiNull { static constexpr bool PERM = true; __device__ __forceinline__ void operator()(const f32x4 (&acc)[2][2][4][2], const pg8::Unit& u, int wr, int wc, int fr, int fq) const {
    f32x4 t = {0.f, 0.f, 0.f, 0.f};
#pragma unroll
    for (int a = 0; a < 2; ++a)
#pragma unroll
        for (int b = 0; b < 2; ++b)
#pragma unroll
            for (int m = 0; m < 4; ++m)
#pragma unroll
                for (int n = 0; n < 2; ++n) t += acc[a][b][m][n];
    if (t[0] + t[1] + t[2] + t[3] == 1.2345e-33f) __builtin_amdgcn_s_sleep(1); } };
struct EpiSwiglu8 {
    static constexpr bool PERM = true;
    unsigned char* H8;
    __device__ __forceinline__ void operator()(const f32x4 (&acc)[2][2][4][2], const pg8::Unit& u, int wr, int wc, int fr, int fq) const {
        const int row0 = u.pm * 256 + wr * 64 + fr, col0 = u.pn * 128 + wc * 32 + 8 * fq;
        const float sc = (float)(1 << F8_SA);
#pragma unroll
        for (int ai = 0; ai < 2; ++ai)
#pragma unroll
            for (int m = 0; m < 4; ++m) {
                unsigned char* rowp = H8 + (size_t)(row0 + ai * 128 + m * 16) * DFF + col0;
                const f32x4 a0 = acc[ai][0][m][0], a1 = acc[ai][0][m][1], b0 = acc[ai][1][m][0], b1 = acc[ai][1][m][1];
                int w0 = 0, w1 = 0;
                w0 = __builtin_amdgcn_cvt_pk_fp8_f32(fast_silu(a0[0]) * b0[0] * sc, fast_silu(a0[1]) * b0[1] * sc, w0, false); w0 = __builtin_amdgcn_cvt_pk_fp8_f32(fast_silu(a0[2]) * b0[2] * sc, fast_silu(a0[3]) * b0[3] * sc, w0, true);
                w1 = __builtin_amdgcn_cvt_pk_fp8_f32(fast_silu(a1[0]) * b1[0] * sc, fast_silu(a1[1]) * b1[1] * sc, w1, false); w1 = __builtin_amdgcn_cvt_pk_fp8_f32(fast_silu(a1[2]) * b1[2] * sc, fast_silu(a1[3]) * b1[3] * sc, w1, true);
                *(u32x2*)rowp = (u32x2){(unsigned)w0, (unsigned)w1};
            }
    }
};
template <bool ATOMIC> struct EpiResid {
    static constexpr bool PERM = false;
    const float* xin; float* xout; const float* gate; float gs; int pm_off; int wt;
    __device__ __forceinline__ void operator()(const f32x4 (&acc)[2][2][4][2], const pg8::Unit& u, int wr, int wc, int fr, int fq) const {
        const int row0 = u.pm * 256 + wr * 64 + fr, col0 = u.pn * 256 + wc * 32 + 4 * fq;
        const float* gp = gate + (size_t)panel_v(u.pm + pm_off) * NMOD + col0;
        f32x4 gv[2][2];
#pragma unroll
        for (int bj = 0; bj < 2; ++bj)
#pragma unroll
            for (int n = 0; n < 2; ++n) gv[bj][n] = *(const f32x4*)(gp + bj * 128 + n * 16);
        asm volatile("" : "+v"(gv[0][0]), "+v"(gv[0][1]), "+v"(gv[1][0]), "+v"(gv[1][1]));
#pragma unroll
        for (int bj = 0; bj < 2; ++bj)
#pragma unroll
            for (int n = 0; n < 2; ++n) gv[bj][n] = gv[bj][n] * gs;
#pragma unroll
        for (int ai = 0; ai < 2; ++ai) {
            f32x4 xi[4][2][2];
            if (!ATOMIC) {
#pragma unroll
                for (int m = 0; m < 4; ++m)
#pragma unroll
                    for (int bj = 0; bj < 2; ++bj)
#pragma unroll
                        for (int n = 0; n < 2; ++n) xi[m][bj][n] = *(const f32x4*)(xin + (size_t)(row0 + ai * 128 + m * 16) * D + col0 + bj * 128 + n * 16);
                asm volatile("" ::: "memory");
            }
#pragma unroll
            for (int m = 0; m < 4; ++m) {
                const size_t off = (size_t)(row0 + ai * 128 + m * 16) * D + col0;
#pragma unroll
                for (int bj = 0; bj < 2; ++bj)
#pragma unroll
                    for (int n = 0; n < 2; ++n) {
                        const f32x4 v = gv[bj][n] * acc[ai][bj][m][n];
                        if (!ATOMIC) *(f32x4*)(xout + off + bj * 128 + n * 16) = xi[m][bj][n] + v;
                        else { float* p = xout + off + bj * 128 + n * 16; unsafeAtomicAdd(p, v[0]); unsafeAtomicAdd(p + 1, v[1]); unsafeAtomicAdd(p + 2, v[2]); unsafeAtomicAdd(p + 3, v[3]); }
                    }
            }
            if (!ATOMIC) asm volatile("" ::: "memory");
        }
    }
};
struct EpiPart {
    static constexpr bool PERM = false;
    float* part; const float* gate; float gs;
    __device__ __forceinline__ void operator()(const f32x4 (&acc)[2][2][4][2], const pg8::Unit& u, int wr, int wc, int fr, int fq) const {
        const int row0 = u.pm * 256 + wr * 64 + fr, col0 = u.pn * 256 + wc * 32 + 4 * fq;
        const float* gp = gate + (size_t)2 * NMOD + col0; float* pb = part + (size_t)u.pz * MC * D;
        f32x4 gv[2][2];
#pragma unroll
        for (int bj = 0; bj < 2; ++bj)
#pragma unroll
            for (int n = 0; n < 2; ++n) gv[bj][n] = *(const f32x4*)(gp + bj * 128 + n * 16) * gs;
#pragma unroll
        for (int ai = 0; ai < 2; ++ai)
#pragma unroll
            for (int m = 0; m < 4; ++m) {
                const size_t off = (size_t)(row0 + ai * 128 + m * 16) * D + col0;
#pragma unroll
                for (int bj = 0; bj < 2; ++bj)
#pragma unroll
                    for (int n = 0; n < 2; ++n) *(f32x4*)(pb + off + bj * 128 + n * 16) = gv[bj][n] * acc[ai][bj][m][n];
            }
    }
};
struct EpiStoreBf16 {
    static constexpr bool PERM = true;
    bf16_t* O; int ldo; float scale; long zstride;
    __device__ __forceinline__ void operator()(const f32x4 (&acc)[2][2][4][2], const pg8::Unit& u, int wr, int wc, int fr, int fq) const {
        const int row0 = u.pm * 256 + wr * 64 + fr, col0 = u.pn * 256 + wc * 32 + 8 * fq;
        bf16_t* base = O + (size_t)u.pz * zstride;
#pragma unroll
        for (int ai = 0; ai < 2; ++ai)
#pragma unroll
            for (int m = 0; m < 4; ++m) {
                bf16_t* rowp = base + (size_t)(row0 + ai * 128 + m * 16) * ldo + col0;
#pragma unroll
                for (int bj = 0; bj < 2; ++bj) { const f32x4 v0 = acc[ai][bj][m][0] * scale, v1 = acc[ai][bj][m][1] * scale;
                    u32x4 w; w.x = cvt_pk_bf16(v0[0], v0[1]); w.y = cvt_pk_bf16(v0[2], v0[3]); w.z = cvt_pk_bf16(v1[0], v1[1]); w.w = cvt_pk_bf16(v1[2], v1[3]);
                    *(u32x4*)(rowp + bj * 128) = w; }
            }
    }
};
struct EpiF1 {
    static constexpr bool PERM = true;
    bf16_t* BT2; int L;
    __device__ __forceinline__ void operator()(const f32x4 (&acc)[2][2][4][2], const pg8::Unit& u, int wr, int wc, int fr, int fq) const {
        const int b = u.pz >> 2, g = u.pz & 3;
        const int row0 = g * 512 + (u.pm & 1) * 256 + wr * 64 + fr, col0 = (u.pm >> 1) * L + u.pn * 256 + wc * 32 + 8 * fq;
        bf16_t* base = BT2 + (size_t)b * 2048 * 2 * L;
#pragma unroll
        for (int ai = 0; ai < 2; ++ai)
#pragma unroll
            for (int m = 0; m < 4; ++m) {
                bf16_t* rowp = base + (size_t)(row0 + ai * 128 + m * 16) * (2 * L) + col0;
#pragma unroll
                for (int bj = 0; bj < 2; ++bj) { const f32x4 v0 = acc[ai][bj][m][0], v1 = acc[ai][bj][m][1];
                    u32x4 w; w.x = cvt_pk_bf16(v0[0], v0[1]); w.y = cvt_pk_bf16(v0[2], v0[3]); w.z = cvt_pk_bf16(v1[0], v1[1]); w.w = cvt_pk_bf16(v1[2], v1[3]);
                    *(u32x4*)(rowp + bj * 128) = w; }
            }
    }
};

struct EpiF1b {
    static constexpr bool PERM = true;
    bf16_t* BT2;
    __device__ __forceinline__ void operator()(const f32x4 (&acc)[2][2][4][2], const pg8::Unit& u, int wr, int wc, int fr, int fq) const {
        const int bt = u.pz >> 2, g = u.pz & 3, ri = u.pm >> 1;
        const int ch0 = g * 512 + (u.pm & 1) * 256 + wr * 64 + fr, a0 = wc * 32 + 8 * fq;
#pragma unroll
        for (int ai = 0; ai < 2; ++ai)
#pragma unroll
            for (int m = 0; m < 4; ++m) {
                bf16_t* rowp = BT2 + ((((size_t)bt * 2048 + ch0 + ai * 128 + m * 16) * 16 + u.pn) * 2 + ri) * 256 + a0;
#pragma unroll
                for (int bj = 0; bj < 2; ++bj) { const f32x4 v0 = acc[ai][bj][m][0], v1 = acc[ai][bj][m][1];
                    u32x4 w; w.x = cvt_pk_bf16(v0[0], v0[1]); w.y = cvt_pk_bf16(v0[2], v0[3]); w.z = cvt_pk_bf16(v1[0], v1[1]); w.w = cvt_pk_bf16(v1[2], v1[3]);
                    *(u32x4*)(rowp + bj * 128) = w; }
            }
    }
};
struct EpiTw {
    static constexpr bool PERM = true;
    bf16_t* TW;
    __device__ __forceinline__ void operator()(const f32x4 (&acc)[2][2][4][2], const pg8::Unit& u, int wr, int wc, int fr, int fq) const {
        const int b0 = 8 * (fq & 1);
#pragma unroll
        for (int m = 0; m < 4; ++m) {
            const int k1 = u.pm * 128 + wr * 64 + m * 16 + fr;
            float cs[8], sn[8];
#pragma unroll
            for (int e = 0; e < 8; ++e) { const float ph = (float)(((b0 + e) * k1) & 4095) * (1.f / 4096.f); cs[e] = __builtin_amdgcn_cosf(ph); sn[e] = __builtin_amdgcn_sinf(ph); }
#pragma unroll
            for (int bj = 0; bj < 2; ++bj) {
                const int ch = u.pn * 16 + bj * 8 + wc * 2 + (fq >> 1);
                const f32x4 r0 = acc[0][bj][m][0], r1 = acc[0][bj][m][1], i0 = acc[1][bj][m][0], i1 = acc[1][bj][m][1];
                const float tr[8] = {r0[0], r0[1], r0[2], r0[3], r1[0], r1[1], r1[2], r1[3]}, ti[8] = {i0[0], i0[1], i0[2], i0[3], i1[0], i1[1], i1[2], i1[3]};
                float orr[8], oi[8];
#pragma unroll
                for (int e = 0; e < 8; ++e) { orr[e] = tr[e] * cs[e] + ti[e] * sn[e]; oi[e] = ti[e] * cs[e] - tr[e] * sn[e]; }
                bf16_t* dst = TW + ((((size_t)u.pz * 2048 + ch) * 256 + k1) * 2) * 16 + b0;
                *(u32x4*)dst = (u32x4){cvt_pk_bf16(orr[0], orr[1]), cvt_pk_bf16(orr[2], orr[3]), cvt_pk_bf16(orr[4], orr[5]), cvt_pk_bf16(orr[6], orr[7])};
                *(u32x4*)(dst + 16) = (u32x4){cvt_pk_bf16(oi[0], oi[1]), cvt_pk_bf16(oi[2], oi[3]), cvt_pk_bf16(oi[4], oi[5]), cvt_pk_bf16(oi[6], oi[7])};
            }
        }
    }
};
struct EpiFS2 {
    static constexpr bool PERM = true;
    bf16_t* O; float scale;
    __device__ __forceinline__ void operator()(const f32x4 (&acc)[2][2][4][2], const pg8::Unit& u, int wr, int wc, int fr, int fq) const {
        const int bt = u.pz >> 4, k1g = u.pz & 15, col0 = u.pn * 256 + wc * 32 + 8 * fq;
#pragma unroll
        for (int ai = 0; ai < 2; ++ai)
#pragma unroll
            for (int m = 0; m < 4; ++m) {
                const int R = ai * 128 + wr * 64 + m * 16 + fr, k = 16 * k1g + (R >> 4) + 256 * (R & 15);
                bf16_t* rowp = O + ((size_t)bt * 4096 + k) * D + col0;
#pragma unroll
                for (int bj = 0; bj < 2; ++bj) { const f32x4 v0 = acc[ai][bj][m][0] * scale, v1 = acc[ai][bj][m][1] * scale;
                    u32x4 w; w.x = cvt_pk_bf16(v0[0], v0[1]); w.y = cvt_pk_bf16(v0[2], v0[3]); w.z = cvt_pk_bf16(v1[0], v1[1]); w.w = cvt_pk_bf16(v1[2], v1[3]);
                    *(u32x4*)(rowp + bj * 128) = w; }
            }
    }
};

struct Args { const float* in[21]; float* out; unsigned char* ws; int ph_lo, ph_hi; };
struct Frame { LAS unsigned char* lds; };
typedef const __attribute__((address_space(4))) Args* KArgsPtr;
__device__ __forceinline__ KArgsPtr ka_ptr() { KArgsPtr p = (KArgsPtr)__builtin_amdgcn_kernarg_segment_ptr(); asm volatile("" : "+s"(p)); return p; }
#define KA_LOAD() const KArgsPtr KA = ka_ptr()
#define WSP(T, off) ((T*)(KA->ws + (off)))
#define PHASE_IDS() KA_LOAD(); int tz_ = threadIdx.x; asm volatile("" : "+v"(tz_)); const int tid = tz_, lane = tz_ & 63, wave = __builtin_amdgcn_readfirstlane(tz_ >> 6); const int G_ = (int)gridDim.x, vcu_ = (G_ % 8 == 0) ? ((int)blockIdx.x % 8) * (G_ / 8) + (int)blockIdx.x / 8 : (int)blockIdx.x; const int gw = vcu_ * NWAVES + wave, NGW = G_ * NWAVES; (void)tid; (void)lane; (void)gw; (void)NGW

__device__ __forceinline__ void transpose_item(const float* W, int N, int k0, int n0, bf16_t* WT, int ldt, int drow0, LAS float* scr, int lane) {
#pragma unroll 8
    for (int i = 0; i < 32; ++i) { const int kk = 2 * i + (lane >> 5); scr[kk * 33 + (lane & 31)] = MK_NT_PRO ? __builtin_nontemporal_load(W + (size_t)(k0 + kk) * N + n0 + (lane & 31)) : W[(size_t)(k0 + kk) * N + n0 + (lane & 31)]; }
    asm volatile("s_waitcnt lgkmcnt(0)" ::: "memory");
    const int c = lane & 7;
#pragma unroll
    for (int j = 0; j < 4; ++j) { const int n = (lane >> 3) + 8 * j; const LAS float* s = scr + (8 * c) * 33 + n;
        u32x4 o; o.x = cvt_pk_bf16(s[0 * 33], s[1 * 33]); o.y = cvt_pk_bf16(s[2 * 33], s[3 * 33]); o.z = cvt_pk_bf16(s[4 * 33], s[5 * 33]); o.w = cvt_pk_bf16(s[6 * 33], s[7 * 33]);
        if (MK_NT_PST) __builtin_nontemporal_store(o, (u32x4*)(WT + (size_t)(drow0 + n) * ldt + k0 + 8 * c)); else *(u32x4*)(WT + (size_t)(drow0 + n) * ldt + k0 + 8 * c) = o; }
    asm volatile("s_waitcnt lgkmcnt(0)" ::: "memory");
}
__device__ __forceinline__ void transpose_item8(const float* W, int N, int k0, int n0, unsigned char* WT, int ldt, int drow0, LAS float* scr, int lane) {
#pragma unroll 8
    for (int i = 0; i < 32; ++i) { const int kk = 2 * i + (lane >> 5); scr[kk * 33 + (lane & 31)] = MK_NT_PRO ? __builtin_nontemporal_load(W + (size_t)(k0 + kk) * N + n0 + (lane & 31)) : W[(size_t)(k0 + kk) * N + n0 + (lane & 31)]; }
    asm volatile("s_waitcnt lgkmcnt(0)" ::: "memory");
    const int c = lane & 7; const float sc = (float)(1 << F8_SW);
#pragma unroll
    for (int j = 0; j < 4; ++j) { const int n = (lane >> 3) + 8 * j; const LAS float* s = scr + (8 * c) * 33 + n;
        int w0 = 0, w1 = 0;
        w0 = __builtin_amdgcn_cvt_pk_fp8_f32(s[0 * 33] * sc, s[1 * 33] * sc, w0, false); w0 = __builtin_amdgcn_cvt_pk_fp8_f32(s[2 * 33] * sc, s[3 * 33] * sc, w0, true);
        w1 = __builtin_amdgcn_cvt_pk_fp8_f32(s[4 * 33] * sc, s[5 * 33] * sc, w1, false); w1 = __builtin_amdgcn_cvt_pk_fp8_f32(s[6 * 33] * sc, s[7 * 33] * sc, w1, true);
        *(u32x2*)(WT + (size_t)(drow0 + n) * ldt + k0 + 8 * c) = (u32x2){(unsigned)w0, (unsigned)w1}; }
    asm volatile("s_waitcnt lgkmcnt(0)" ::: "memory");
}
__device__ __forceinline__ void ph_weights(Frame& F) {
    PHASE_IDS();
    LAS float* scr = (LAS float*)(F.lds + wave * 16384);
    constexpr int I_FFN = 32 * 176, I_IN = 32 * 177, I_SQ = 32 * 64;
    constexpr int NITEMS = 24 * I_FFN + 2 * I_IN + 4 * I_SQ;
    for (int it = gw; it < NITEMS; it += NGW) {
        int r = it;
        if (r < 24 * I_FFN) {
            const int mat = r / I_FFN, item = r % I_FFN, ls = mat / 3, which = mat % 3;
            if (which < 2) {
                const int kb = item / 176, nb = item % 176, n0 = nb * 32;
                transpose_item((which ? KA->in[8] : KA->in[7]) + (size_t)ls * D * DFF, DFF, kb * 64, n0, WSP(bf16_t, WS_W13) + (size_t)ls * 2 * DFF * D, D, 256 * (n0 >> 7) + (n0 & 127) + which * 128, scr, lane);
            } else {
                const int kb = item / 64, nb = item % 64, n0 = nb * 32;
                if ((MK_F8_MASK >> ls) & 1) transpose_item8(KA->in[9] + (size_t)ls * DFF * D, D, kb * 64, n0, WSP(unsigned char, WS_W28) + (size_t)ls * D * DFF, DFF, n0, scr, lane);
                else transpose_item(KA->in[9] + (size_t)ls * DFF * D, D, kb * 64, n0, WSP(bf16_t, WS_W2) + (size_t)ls * D * HP, HP, n0, scr, lane);
            }
            continue;
        }
        r -= 24 * I_FFN;
        if (r < 2 * I_IN) {
            const int j = r / I_IN, item = r % I_IN, kb = item / 177, nb = item % 177, n0 = nb * 32;
            if (n0 < NPJ) transpose_item(KA->in[10] + (size_t)j * D * INW, INW, kb * 64, n0, WSP(bf16_t, WS_WIN) + (size_t)j * NPJ * D, D, n0, scr, lane);
            else transpose_item(KA->in[10] + (size_t)j * D * INW, INW, kb * 64, n0, WSP(bf16_t, WS_WDT) + (size_t)j * 32 * D, D, 0, scr, lane);
            continue;
        }
        r -= 2 * I_IN;
        { const int mat = r / I_SQ, item = r % I_SQ, kb = item / 64, nb = item % 64, n0 = nb * 32, j = mat & 1;
          const float* src = (mat < 2 ? KA->in[11] : KA->in[20]) + (size_t)j * D * D;
          bf16_t* dst = (mat < 2 ? WSP(bf16_t, WS_WOUT) : WSP(bf16_t, WS_WF)) + (size_t)j * D * D;
          transpose_item(src, D, kb * 64, n0, dst, D, n0, scr, lane); }
    }
}
__device__ __forceinline__ void ph_mod(Frame& F) {
    PHASE_IDS();
    LAS float* sv = (LAS float*)F.lds;
    LAS float* red = (LAS float*)(F.lds + 24576);
    for (int i = tid; i < 3 * D; i += NTHR) { const int v = i / D, k = i % D; const float x = v < 2 ? KA->in[1][v * D + k] : KA->in[3][k]; sv[i] = silu_acc(x); }
    __syncthreads();
    const int cq = tid % 24, ks = tid / 24;
    for (int it = vcu_; it < 4 * 192; it += G_) {
        const int l = it / 192, cb = it % 192;
        if (ks < 21) {
            const float* w = KA->in[4] + (size_t)l * D * NMOD + cb * 96 + cq * 4;
            const int kbeg = ks * 98, kend = kbeg + 98 < D ? kbeg + 98 : D;
            f32x4 a0 = {0.f, 0.f, 0.f, 0.f}, a1 = a0, a2 = a0;
#pragma unroll 14
            for (int k = kbeg; k < kend; ++k) { const f32x4 wv = MK_NT_PRO ? __builtin_nontemporal_load((const f32x4*)(w + (size_t)k * NMOD)) : *(const f32x4*)(w + (size_t)k * NMOD); a0 += wv * sv[k]; a1 += wv * sv[D + k]; a2 += wv * sv[2 * D + k]; }
            *(LAS f32x4*)(red + (ks * 3 + 0) * 96 + cq * 4) = a0; *(LAS f32x4*)(red + (ks * 3 + 1) * 96 + cq * 4) = a1; *(LAS f32x4*)(red + (ks * 3 + 2) * 96 + cq * 4) = a2;
        }
        __syncthreads();
        if (tid < 288) { const int v = tid / 96, c = tid % 96; float s = 0.f;
#pragma unroll
            for (int q = 0; q < 21; ++q) s += red[(q * 3 + v) * 96 + c];
            const int j = cb * 96 + c; WSP(float, WS_MOD)[(size_t)(l * 3 + v) * NMOD + j] = s + KA->in[5][l * NMOD + j]; }
        __syncthreads();
    }
}
__device__ __forceinline__ void ph_tables(Frame& F) {
    PHASE_IDS();
    const size_t gt = (size_t)vcu_ * NTHR + tid, NT = (size_t)G_ * NTHR;
    for (size_t it = gt; it < (size_t)1024 * 64; it += NT) { const int mp = (int)(it >> 6), c0 = (int)(it & 63) * 8, m = mp & 511; unsigned o[4];
#pragma unroll
        for (int e = 0; e < 4; ++e) { const float x0 = (float)((m * (c0 + 2 * e)) & 511) * (1.f / 512.f), x1 = (float)((m * (c0 + 2 * e + 1)) & 511) * (1.f / 512.f);
            o[e] = mp < 512 ? cvt_pk_bf16(__builtin_amdgcn_cosf(x0), __builtin_amdgcn_cosf(x1)) : cvt_pk_bf16(__builtin_amdgcn_sinf(x0), __builtin_amdgcn_sinf(x1)); }
        *(u32x4*)(WSP(bf16_t, WS_DFTC) + (size_t)mp * 512 + c0) = (u32x4){o[0], o[1], o[2], o[3]}; }
    for (size_t it = gt; it < (size_t)256 * 32; it += NT) { const int k = (int)(it >> 5), l0 = (int)(it & 31) * 8; unsigned c[4], s[4];
#pragma unroll
        for (int e = 0; e < 4; ++e) { const float x0 = (float)((k * (l0 + 2 * e)) & 255) * (1.f / 256.f), x1 = (float)((k * (l0 + 2 * e + 1)) & 255) * (1.f / 256.f);
            c[e] = cvt_pk_bf16(__builtin_amdgcn_cosf(x0), __builtin_amdgcn_cosf(x1)); s[e] = cvt_pk_bf16(-__builtin_amdgcn_sinf(x0), -__builtin_amdgcn_sinf(x1)); }
        bf16_t* rowp = WSP(bf16_t, WS_DFT256) + (size_t)k * 512 + l0; *(u32x4*)rowp = (u32x4){c[0], c[1], c[2], c[3]}; *(u32x4*)(rowp + 256) = (u32x4){s[0], s[1], s[2], s[3]}; }
    for (size_t it = gt; it < (size_t)512 * 64; it += NT) { const int R = (int)(it >> 6), c0 = (int)(it & 63) * 8, k1 = (R >> 8) * 128 + (R & 127), rip = (R >> 7) & 1, ri = c0 >> 8; unsigned o[4];
#pragma unroll
        for (int e = 0; e < 4; ++e) { float v[2];
#pragma unroll
            for (int hh = 0; hh < 2; ++hh) { const int a = (c0 + 2 * e + hh) & 255; const float x = (float)((a * k1) & 255) * (1.f / 256.f), c = __builtin_amdgcn_cosf(x), sn = __builtin_amdgcn_sinf(x);
                v[hh] = rip == 0 ? (ri == 0 ? c : -sn) : (ri == 0 ? -sn : -c); }
            o[e] = cvt_pk_bf16(v[0], v[1]); }
        *(u32x4*)(WSP(bf16_t, WS_F1MAT) + (size_t)R * 512 + c0) = (u32x4){o[0], o[1], o[2], o[3]}; }
    for (size_t it = gt; it < (size_t)256 * 64; it += NT) { const int R = (int)(it >> 6), c0 = (int)(it & 63) * 8, k1lp = R >> 4, k2 = R & 15, k1l = c0 >> 5, ri = (c0 >> 4) & 1; unsigned o[4];
#pragma unroll
        for (int e = 0; e < 4; ++e) { float v[2];
#pragma unroll
            for (int hh = 0; hh < 2; ++hh) { const int b = (c0 + 2 * e + hh) & 15; const float x = (float)((b * k2) & 15) * (1.f / 16.f);
                v[hh] = k1l == k1lp ? (ri == 0 ? __builtin_amdgcn_cosf(x) : __builtin_amdgcn_sinf(x)) : 0.f; }
            o[e] = cvt_pk_bf16(v[0], v[1]); }
        *(u32x4*)(WSP(bf16_t, WS_F2MAT) + (size_t)R * 512 + c0) = (u32x4){o[0], o[1], o[2], o[3]}; }
    for (size_t it = gt; it < 64 * 32; it += NT) { const int pos = (int)(it >> 5), j = (int)(it & 31); const float a = (float)pos * powf(10000.f, -(float)j / 32.f); WSP(f32x2, WS_ROPE)[it] = (f32x2){cosf(a), sinf(a)}; }
}

__device__ __forceinline__ void ph_norm(Frame& F, const float* g, const float* modl, int s, int row_lo, int nrows, int npart, const float* xlat, const float* xctx) {
    PHASE_IDS();
    float* XR = WSP(float, WS_XR); bf16_t* XN = WSP(bf16_t, WS_XN); const float* PART = WSP(float, WS_PART);
    const int nmain = (npart > 0 && nrows > ML) ? ML : nrows;
    f32x4 v[8], nx[8];
    const int rfirst = row_lo + gw;
    if (rfirst < nmain) { const f32x4* xi = (const f32x4*)(rfirst < ML ? xlat + (size_t)rfirst * D : xctx + (size_t)(rfirst - ML) * D) + lane;
#pragma unroll
        for (int j = 0; j < 8; ++j) v[j] = MK_NT_X ? __builtin_nontemporal_load(xi + 64 * j) : xi[64 * j]; }
    for (int row = rfirst; row < nmain; row += NGW) {
        const int nrow = row + NGW;
        if (nrow < nmain) { const f32x4* xi = (const f32x4*)(nrow < ML ? xlat + (size_t)nrow * D : xctx + (size_t)(nrow - ML) * D) + lane;
#pragma unroll
            for (int j = 0; j < 8; ++j) nx[j] = MK_NT_X ? __builtin_nontemporal_load(xi + 64 * j) : xi[64 * j]; }
        const float* md = modl + (size_t)row_v(row) * NMOD;
        f32x4 gg[8], sc[8], sh[8];
#pragma unroll
        for (int j = 0; j < 8; ++j) { const int c = 4 * lane + 256 * j; gg[j] = *(const f32x4*)(g + c); sc[j] = *(const f32x4*)(md + (s + 1) * D + c); sh[j] = *(const f32x4*)(md + s * D + c); }
        float ss = 0.f;
#pragma unroll
        for (int j = 0; j < 8; ++j) ss += (v[j].x * v[j].x + v[j].y * v[j].y) + (v[j].z * v[j].z + v[j].w * v[j].w);
        const float r = 1.0f / sqrtf(wave_sum(ss, lane) * (1.f / D) + EPS);
        u32x2* o8 = (u32x2*)(XN + (size_t)row * D) + lane;
#pragma unroll
        for (int j = 0; j < 8; ++j) { const f32x4 y = v[j] * r * gg[j] * (sc[j] + 1.0f) + sh[j]; o8[64 * j] = (u32x2){cvt_pk_bf16(y.x, y.y), cvt_pk_bf16(y.z, y.w)}; }
#pragma unroll
        for (int j = 0; j < 8; ++j) v[j] = nx[j];
    }
    if (nmain < nrows) {
        const float* md = modl + (size_t)2 * NMOD;
        LAS float* red = (LAS float*)F.lds;
        const int cbase = (wave & 3) * 512 + 4 * lane;
        for (int rb = vcu_ * 2; rb < nrows - ML; rb += G_ * 2) {
            const int row = ML + rb + (wave >> 2);
            const float* xi = xctx + (size_t)(row - ML) * D + cbase; float* xr = XR + (size_t)row * D + cbase;
            f32x4 w0 = *(const f32x4*)xi, w1 = *(const f32x4*)(xi + 256);
            for (int sp = 0; sp < npart; sp += 4) {
                f32x4 t[4][2];
#pragma unroll
                for (int q = 0; q < 4; ++q) { const int spq = sp + q < npart ? sp + q : sp; const float* pr = PART + ((size_t)spq * MC + (row - ML)) * D + cbase; t[q][0] = *(const f32x4*)pr; t[q][1] = *(const f32x4*)(pr + 256); }
                asm volatile("" ::: "memory");
#pragma unroll
                for (int q = 0; q < 4; ++q) if (sp + q < npart) { w0 += t[q][0]; w1 += t[q][1]; }
            }
            *(f32x4*)xr = w0; *(f32x4*)(xr + 256) = w1;
            float ss = (w0.x * w0.x + w0.y * w0.y) + (w0.z * w0.z + w0.w * w0.w) + (w1.x * w1.x + w1.y * w1.y) + (w1.z * w1.z + w1.w * w1.w);
            ss = wave_sum(ss, lane);
            if (lane == 0) red[wave] = ss;
            __syncthreads();
            const int w4 = wave & ~3; const float tot = (red[w4] + red[w4 + 1]) + (red[w4 + 2] + red[w4 + 3]);
            const float r = 1.0f / sqrtf(tot * (1.f / D) + EPS);
            bf16_t* xo = XN + (size_t)row * D + cbase;
#pragma unroll
            for (int j = 0; j < 2; ++j) { const int c = cbase + 256 * j; const f32x4 ww = j ? w1 : w0;
                const f32x4 y = ww * r * *(const f32x4*)(g + c) * (*(const f32x4*)(md + (s + 1) * D + c) + 1.0f) + *(const f32x4*)(md + s * D + c);
                *(u32x2*)(xo + 256 * j) = (u32x2){cvt_pk_bf16(y.x, y.y), cvt_pk_bf16(y.z, y.w)}; }
            __syncthreads();
        }
    }
}
__device__ __forceinline__ void panel_publish(KArgsPtr KA, int site) {
    pg8::Order S; S.init(ML, D, 1, (int)gridDim.x, (int)blockIdx.x); pg8::Unit u; if (!S.next(0, u)) return;
    if (threadIdx.x == 0) {
        asm volatile("s_waitcnt vmcnt(0)" ::: "memory");
        (void)__hip_atomic_fetch_add(WSP(unsigned, WS_CTL) + CW_PCNT + (site * 32 + u.pm) * 64, 1u, __ATOMIC_RELAXED, __HIP_MEMORY_SCOPE_AGENT);
    }
}
__device__ __forceinline__ void panel_norm(Frame& F, int site, const float* g, const float* modl, int s) {
    PHASE_IDS();
    pg8::Order S; S.init(ML, D, 1, G_, (int)blockIdx.x); pg8::Unit u; if (!S.next(0, u)) return;
    if (tid == 0) {
        unsigned* ctr = WSP(unsigned, WS_CTL) + CW_PCNT + (site * 32 + u.pm) * 64; unsigned* tmo = WSP(unsigned, WS_CTL) + CW_PTMO; unsigned sp = 0;
        while (__hip_atomic_load(ctr, __ATOMIC_RELAXED, __HIP_MEMORY_SCOPE_AGENT) < 8u) { __builtin_amdgcn_s_sleep(1);
            if ((++sp & 255u) == 0u) { if (__hip_atomic_load(tmo, __ATOMIC_RELAXED, __HIP_MEMORY_SCOPE_AGENT)) break; if (sp > (1u << 18)) { atomicAdd(tmo, 1u); break; } } }
        __builtin_amdgcn_fence(__ATOMIC_ACQUIRE, "agent"); asm volatile("s_waitcnt vmcnt(0)" ::: "memory");
    }
    __syncthreads();
    const float* XR = WSP(float, WS_XR); bf16_t* XN = WSP(bf16_t, WS_XN);
    const int rbase = u.pm * 256 + u.pn * 32 + wave * 4;
    const float* md = modl + (size_t)panel_v(u.pm) * NMOD;
    f32x4 gc[8], sh[8];
#pragma unroll
    for (int j = 0; j < 8; ++j) { const int c = 4 * lane + 256 * j; gc[j] = *(const f32x4*)(g + c) * (*(const f32x4*)(md + (s + 1) * D + c) + 1.0f); sh[j] = *(const f32x4*)(md + s * D + c); }
    f32x4 v[4][8];
#pragma unroll
    for (int i = 0; i < 4; ++i) { const f32x4* xi = (const f32x4*)(XR + (size_t)(rbase + i) * D) + lane;
#pragma unroll
        for (int j = 0; j < 8; ++j) v[i][j] = xi[64 * j]; }
#pragma unroll
    for (int i = 0; i < 4; ++i) {
        float ss = 0.f;
#pragma unroll
        for (int j = 0; j < 8; ++j) ss += (v[i][j].x * v[i][j].x + v[i][j].y * v[i][j].y) + (v[i][j].z * v[i][j].z + v[i][j].w * v[i][j].w);
        const float r = 1.0f / sqrtf(wave_sum(ss, lane) * (1.f / D) + EPS);
        u32x2* o8 = (u32x2*)(XN + (size_t)(rbase + i) * D) + lane;
#pragma unroll
        for (int j = 0; j < 8; ++j) { const f32x4 y = v[i][j] * r * gc[j] + sh[j]; o8[64 * j] = (u32x2){cvt_pk_bf16(y.x, y.y), cvt_pk_bf16(y.z, y.w)}; }
    }
}
__device__ __forceinline__ void ph_dt(Frame& F, int j) {
    PHASE_IDS();
    const bf16_t* XN = WSP(bf16_t, WS_XN); const bf16_t* W = WSP(bf16_t, WS_WDT) + (size_t)j * 32 * D;
    const float* dt_bias = KA->in[16] + j * 32; const float* a_log = KA->in[17] + j * 32; float* DT = WSP(float, WS_DT); float* DA = WSP(float, WS_DA);
    LAS float* part = (LAS float*)F.lds;
    const int l15 = lane & 15, q = lane >> 4, slot = wave >> 1, kh = wave & 1;
    for (int jb = vcu_ * 4; jb < MT / 16; jb += G_ * 4) {
        const int r0 = (jb + slot) * 16;
        const bf16_t* ap = XN + (size_t)(r0 + l15) * D + 1024 * kh + 8 * q; const bf16_t* bp0 = W + (size_t)l15 * D + 1024 * kh + 8 * q; const bf16_t* bp1 = bp0 + 16 * D;
        f32x4 acc0 = {0.f, 0.f, 0.f, 0.f}, acc1 = acc0;
#pragma unroll 1
        for (int kb = 0; kb < 4; ++kb) {
            bf16x8 a[8], b0[8], b1[8];
#pragma unroll
            for (int k = 0; k < 8; ++k) { a[k] = *(const bf16x8*)(ap + 256 * kb + 32 * k); b0[k] = *(const bf16x8*)(bp0 + 256 * kb + 32 * k); b1[k] = *(const bf16x8*)(bp1 + 256 * kb + 32 * k); }
#pragma unroll
            for (int k = 0; k < 8; ++k) { acc0 = __builtin_amdgcn_mfma_f32_16x16x32_bf16(a[k], b0[k], acc0, 0, 0, 0); acc1 = __builtin_amdgcn_mfma_f32_16x16x32_bf16(a[k], b1[k], acc1, 0, 0, 0); }
        }
        *(LAS f32x4*)(part + ((wave * 2 + 0) * 64 + lane) * 4) = acc0; *(LAS f32x4*)(part + ((wave * 2 + 1) * 64 + lane) * 4) = acc1;
        __syncthreads();
        {
            const f32x4 mine = kh ? acc1 : acc0, other = *(const LAS f32x4*)(part + (((wave ^ 1) * 2 + kh) * 64 + lane) * 4);
            const f32x4 sacc = mine + other;
            const int i = kh * 16 + l15; const float bias = dt_bias[i], A = -__expf(a_log[i]);
#pragma unroll
            for (int e = 0; e < 4; ++e) { const int row = r0 + 4 * q + e; const float x = sacc[e] + bias; const float dt = fmaxf(x, 0.f) + log1pf(__expf(-fabsf(x)));
                DT[(size_t)row * 32 + i] = dt; DA[(size_t)row * 32 + i] = dt * A; }
        }
        __syncthreads();
    }
}
__device__ __forceinline__ void ph_qknorm(Frame& F, int j) {
    PHASE_IDS();
    const bf16_t* PROJ = WSP(bf16_t, WS_PROJ); const float* qk_g = KA->in[12] + j * 256;
    bf16_t* QP = WSP(bf16_t, WS_QP); bf16_t* QR = WSP(bf16_t, WS_QR); bf16_t* KR = WSP(bf16_t, WS_KR);
    LAS f32x2* ROPE = (LAS f32x2*)(F.lds + 65536);
    { const f32x2* src = WSP(f32x2, WS_ROPE); for (int i = tid; i < 64 * 32; i += NTHR) ROPE[i] = src[i]; }
    __syncthreads();
    const int a = lane & 7, d0 = a * 16;
    float gq[16], gk[16];
#pragma unroll
    for (int e = 0; e < 16; ++e) { gq[e] = qk_g[d0 + e]; gk[e] = qk_g[128 + d0 + e]; }
    int it = gw;
    u32x4 w0 = {0u, 0u, 0u, 0u}, w1 = w0;
    if (it < MT * 2) { const u32x4* src = (const u32x4*)(PROJ + (size_t)(it >> 1) * NPJ + (it & 1) * 1024 + lane * 16); w0 = MK_NT_X ? __builtin_nontemporal_load(src) : src[0]; w1 = MK_NT_X ? __builtin_nontemporal_load(src + 1) : src[1]; }
    for (; it < MT * 2; it += NGW) {
        const int row = it >> 1, which = it & 1;
        const u32x4 c0 = w0, c1 = w1;
        if (it + NGW < MT * 2) { const int nx = it + NGW; const u32x4* src = (const u32x4*)(PROJ + (size_t)(nx >> 1) * NPJ + (nx & 1) * 1024 + lane * 16); w0 = MK_NT_X ? __builtin_nontemporal_load(src) : src[0]; w1 = MK_NT_X ? __builtin_nontemporal_load(src + 1) : src[1]; }
        float x[16]; const unsigned ww[8] = {c0.x, c0.y, c0.z, c0.w, c1.x, c1.y, c1.z, c1.w};
        float ss = 0.f;
#pragma unroll
        for (int e = 0; e < 8; ++e) { x[2 * e] = bflo(ww[e]); x[2 * e + 1] = bfhi(ww[e]); ss += x[2 * e] * x[2 * e] + x[2 * e + 1] * x[2 * e + 1]; }
        ss += shx(ss, 1, lane); ss += shx(ss, 2, lane); ss += shx(ss, 4, lane);
        const float r = 1.0f / sqrtf(ss * (1.f / 128.f) + EPS);
        float y[16], ro[16];
#pragma unroll
        for (int e = 0; e < 16; ++e) y[e] = x[e] * r * (which ? gk[e] : gq[e]);
        const bool lat = row < ML;
        if (lat) {
            const int t = row & 4095, pos = (a < 4) ? (t >> 6) : (t & 63);
            const LAS f32x2* rp = ROPE + pos * 32 + (a & 1) * 16;
#pragma unroll
            for (int e = 0; e < 16; ++e) { const float p = shx(y[e], 2, lane); const f32x2 cs = rp[e]; ro[e] = (a & 2) ? y[e] * cs.x + p * cs.y : y[e] * cs.x - p * cs.y; }
        } else {
#pragma unroll
            for (int e = 0; e < 16; ++e) ro[e] = y[e];
        }
        u32x4 p0, p1, r0, r1;
        p0.x = cvt_pk_bf16(y[0], y[1]); p0.y = cvt_pk_bf16(y[2], y[3]); p0.z = cvt_pk_bf16(y[4], y[5]); p0.w = cvt_pk_bf16(y[6], y[7]);
        p1.x = cvt_pk_bf16(y[8], y[9]); p1.y = cvt_pk_bf16(y[10], y[11]); p1.z = cvt_pk_bf16(y[12], y[13]); p1.w = cvt_pk_bf16(y[14], y[15]);
        r0.x = cvt_pk_bf16(ro[0], ro[1]); r0.y = cvt_pk_bf16(ro[2], ro[3]); r0.z = cvt_pk_bf16(ro[4], ro[5]); r0.w = cvt_pk_bf16(ro[6], ro[7]);
        r1.x = cvt_pk_bf16(ro[8], ro[9]); r1.y = cvt_pk_bf16(ro[10], ro[11]); r1.z = cvt_pk_bf16(ro[12], ro[13]); r1.w = cvt_pk_bf16(ro[14], ro[15]);
        const size_t o = (size_t)row * 1024 + lane * 16, ok = (size_t)row * KRP + lane * 16;
        if (which == 0) { *(u32x4*)(QP + o) = p0; *(u32x4*)(QP + o + 8) = p1; *(u32x4*)(QR + o) = r0; *(u32x4*)(QR + o + 8) = r1; }
        else { *(u32x4*)(KR + ok) = r0; *(u32x4*)(KR + ok + 8) = r1; }
    }
    __syncthreads();
}
__device__ __forceinline__ void ph_conv(Frame& F, int j) {
    PHASE_IDS();
    const bf16_t* PROJ = WSP(bf16_t, WS_PROJ); const float* cw = KA->in[14] + j * 5 * 1536; const float* cb = KA->in[15] + j * 1536; bf16_t* XBC = WSP(bf16_t, WS_XBC);
    const size_t gt = (size_t)vcu_ * NTHR + tid, NT = (size_t)G_ * NTHR;
    for (size_t it = gt; it < (size_t)MT * 192; it += NT) {
        const int row = (int)(it / 192), ch = (int)(it % 192) * 8;
        int t, L, base; if (row < ML) { t = row & 4095; L = 4096; base = row & ~4095; } else { const int rr = row - ML; t = rr & 255; L = 256; base = ML + (rr & ~255); }
        float acc[8];
#pragma unroll
        for (int e = 0; e < 8; ++e) acc[e] = cb[ch + e];
#pragma unroll
        for (int k = 0; k < 5; ++k) { const int tt = t + k - 2; if (tt >= 0 && tt < L) { const u32x4 w = *(const u32x4*)(PROJ + (size_t)(base + tt) * NPJ + 4096 + ch); const float* cwk = cw + k * 1536 + ch;
                acc[0] += cwk[0] * bflo(w.x); acc[1] += cwk[1] * bfhi(w.x); acc[2] += cwk[2] * bflo(w.y); acc[3] += cwk[3] * bfhi(w.y);
                acc[4] += cwk[4] * bflo(w.z); acc[5] += cwk[5] * bfhi(w.z); acc[6] += cwk[6] * bflo(w.w); acc[7] += cwk[7] * bfhi(w.w); } }
        u32x4 o; o.x = cvt_pk_bf16(silu_acc(acc[0]), silu_acc(acc[1])); o.y = cvt_pk_bf16(silu_acc(acc[2]), silu_acc(acc[3])); o.z = cvt_pk_bf16(silu_acc(acc[4]), silu_acc(acc[5])); o.w = cvt_pk_bf16(silu_acc(acc[6]), silu_acc(acc[7]));
        *(u32x4*)(XBC + (size_t)row * 1536 + ch) = o;
    }
}
__device__ __forceinline__ void ph_ssd_seq(Frame& F) {
    PHASE_IDS();
    const bf16_t* XBC = WSP(bf16_t, WS_XBC); const float* DT = WSP(float, WS_DT); const float* DA = WSP(float, WS_DA);
    for (int id = gw; id < 4096; id += NGW) {
        const int p = id & 63, head = (id >> 6) & 15, dir = (id >> 10) & 1, b = id >> 11, g = head >> 3;
        float h0 = 0.f, h1 = 0.f; float* Y = dir ? WSP(float, WS_YB) : WSP(float, WS_YF);
#pragma unroll 4
        for (int step = 0; step < 256 + 4096; ++step) {
            int row; if (step < 256) { const int t = dir ? 255 - step : step; row = ML + b * 256 + t; } else { const int s = step - 256; const int t = dir ? 4095 - s : s; row = b * 4096 + t; }
            const float dt = DT[row * 32 + dir * 16 + head], da = DA[row * 32 + dir * 16 + head];
            const bf16_t* xr = XBC + (size_t)row * 1536;
            const float x = bf2f(xr[head * 64 + p]);
            const float B0 = bf2f(xr[1024 + g * 128 + lane]), B1 = bf2f(xr[1024 + g * 128 + lane + 64]);
            const float C0 = bf2f(xr[1280 + g * 128 + lane]), C1 = bf2f(xr[1280 + g * 128 + lane + 64]);
            const float dec = __expf(da), dx = dt * x;
            h0 = dec * h0 + dx * B0; h1 = dec * h1 + dx * B1;
            const float y = wave_sum(C0 * h0 + C1 * h1, lane);
            if (lane == 0) Y[(size_t)row * 1024 + head * 64 + p] = y;
        }
    }
}

__device__ __forceinline__ void ph_conv2(Frame& F, int j) {
    PHASE_IDS();
    const bf16_t* PROJ = WSP(bf16_t, WS_PROJ); const float* cw = KA->in[14] + j * 5 * 1536; const float* cb = KA->in[15] + j * 1536; bf16_t* XBC = WSP(bf16_t, WS_XBC);
    for (int wit = gw; wit < (MT / 64) * 24; wit += NGW) {
        const int rg = (wit / 24) * 8 + (lane & 7), ch = (wit % 24) * 64 + (lane >> 3) * 8, row0 = rg * 8;
        int b, t0, L, base, tok0; if (row0 < ML) { b = row0 >> 12; t0 = row0 & 4095; L = 4096; base = b * 4096; tok0 = 256 + t0; } else { const int rr = row0 - ML; b = rr >> 8; t0 = rr & 255; L = 256; base = ML + b * 256; tok0 = t0; }
        u32x4 xin[12];
#pragma unroll
        for (int r = 0; r < 12; ++r) { const int tt = t0 + r - 2; xin[r] = (u32x4){0u, 0u, 0u, 0u}; if (tt >= 0 && tt < L) xin[r] = *(const u32x4*)(PROJ + (size_t)(base + tt) * NPJ + 4096 + ch); }
        float wk[5][8], bia[8];
#pragma unroll
        for (int k = 0; k < 5; ++k) { const f32x4 a = *(const f32x4*)(cw + k * 1536 + ch), c = *(const f32x4*)(cw + k * 1536 + ch + 4); wk[k][0] = a.x; wk[k][1] = a.y; wk[k][2] = a.z; wk[k][3] = a.w; wk[k][4] = c.x; wk[k][5] = c.y; wk[k][6] = c.z; wk[k][7] = c.w; }
        { const f32x4 a = *(const f32x4*)(cb + ch), c = *(const f32x4*)(cb + ch + 4); bia[0] = a.x; bia[1] = a.y; bia[2] = a.z; bia[3] = a.w; bia[4] = c.x; bia[5] = c.y; bia[6] = c.z; bia[7] = c.w; }
        float out[8][8];
#pragma unroll
        for (int o = 0; o < 8; ++o) {
#pragma unroll
            for (int e = 0; e < 8; ++e) out[o][e] = bia[e];
#pragma unroll
            for (int k = 0; k < 5; ++k) { const u32x4 w = xin[o + k];
                out[o][0] += wk[k][0] * bflo(w.x); out[o][1] += wk[k][1] * bfhi(w.x); out[o][2] += wk[k][2] * bflo(w.y); out[o][3] += wk[k][3] * bfhi(w.y);
                out[o][4] += wk[k][4] * bflo(w.z); out[o][5] += wk[k][5] * bfhi(w.z); out[o][6] += wk[k][6] * bflo(w.w); out[o][7] += wk[k][7] * bfhi(w.w); }
#pragma unroll
            for (int e = 0; e < 8; ++e) out[o][e] = fast_silu(out[o][e]);
            *(u32x4*)(XBC + (size_t)(row0 + o) * 1536 + ch) = (u32x4){cvt_pk_bf16(out[o][0], out[o][1]), cvt_pk_bf16(out[o][2], out[o][3]), cvt_pk_bf16(out[o][4], out[o][5]), cvt_pk_bf16(out[o][6], out[o][7])};
        }
        if (ch < 1280) {
            bf16_t* T = ch < 1024 ? WSP(bf16_t, WS_XST) + ((size_t)b * 1024 + ch) * TOKS + tok0 : WSP(bf16_t, WS_BMT) + ((size_t)b * 256 + (ch - 1024)) * TOKS + tok0;
#pragma unroll
            for (int e = 0; e < 8; ++e) *(u32x4*)(T + (size_t)e * TOKS) = (u32x4){cvt_pk_bf16(out[0][e], out[1][e]), cvt_pk_bf16(out[2][e], out[3][e]), cvt_pk_bf16(out[4][e], out[5][e]), cvt_pk_bf16(out[6][e], out[7][e])};
        }
    }
}
__device__ __forceinline__ int chunk_row0(int b, int cc) { return cc < 2 ? ML + b * 256 + cc * 128 : b * 4096 + (cc - 2) * 128; }
__device__ __forceinline__ void chunk_prefix(float a0, float a1, int lane, float& p0, float& p1, float& tot) {
    float s = a0 + a1;
#pragma unroll
    for (int o = 1; o < 64; o <<= 1) { const float t = __int_as_float(__builtin_amdgcn_ds_bpermute((lane - o) << 2, __float_as_int(s))); if (lane >= o) s += t; }
    p1 = s; p0 = s - a1; tot = __int_as_float(__builtin_amdgcn_readlane(__float_as_int(s), 63));
}
__device__ __forceinline__ void ssd1_job(KArgsPtr KA, Frame& F, int job, int lane_, int wave) {
    int lane = lane_; asm volatile("" : "+v"(lane));
    const float* DT = WSP(float, WS_DT); const float* DA = WSP(float, WS_DA); const bf16_t* XST = WSP(bf16_t, WS_XST); const bf16_t* BMT = WSP(bf16_t, WS_BMT);
    float* SST = WSP(float, WS_SST); float* DEC = WSP(float, WS_DEC);
    LAS float* wtab = (LAS float*)(F.lds + wave * 16384);
    const int l15 = lane & 15, q = lane >> 4;
    {
        const int head = job & 15, cc = (job >> 4) % NCC, b = job / (16 * NCC), g = head >> 3, row0 = chunk_row0(b, cc), tokb = cc * 128;
        { const int r = row0 + 2 * lane;
          const float af0 = DA[(size_t)r * 32 + head], af1 = DA[(size_t)(r + 1) * 32 + head], ab0 = DA[(size_t)r * 32 + 16 + head], ab1 = DA[(size_t)(r + 1) * 32 + 16 + head];
          const float df0 = DT[(size_t)r * 32 + head], df1 = DT[(size_t)(r + 1) * 32 + head], db0 = DT[(size_t)r * 32 + 16 + head], db1 = DT[(size_t)(r + 1) * 32 + 16 + head];
          float pf0, pf1, tf, pb0, pb1, tb; chunk_prefix(af0, af1, lane, pf0, pf1, tf); chunk_prefix(ab0, ab1, lane, pb0, pb1, tb);
          wtab[2 * lane] = __expf(tf - pf0) * df0; wtab[2 * lane + 1] = __expf(tf - pf1) * df1;
          wtab[128 + 2 * lane] = __expf(pb0 - ab0) * db0; wtab[128 + 2 * lane + 1] = __expf(pb1 - ab1) * db1;
          if (lane == 0) { DEC[(size_t)(b * NCC + cc) * 32 + head] = __expf(tf); DEC[(size_t)(b * NCC + cc) * 32 + 16 + head] = __expf(tb); } }
        asm volatile("s_waitcnt lgkmcnt(0)" ::: "memory");
        bf16x8 xa[4][4];
#pragma unroll
        for (int pt = 0; pt < 4; ++pt)
#pragma unroll
            for (int ks = 0; ks < 4; ++ks) xa[pt][ks] = *(const bf16x8*)(XST + ((size_t)b * 1024 + head * 64 + 16 * pt + l15) * TOKS + tokb + 32 * ks + 8 * q);
        float wf[4][8], wb[4][8];
#pragma unroll
        for (int ks = 0; ks < 4; ++ks) { const f32x4 a = *(const LAS f32x4*)(wtab + 32 * ks + 8 * q), c = *(const LAS f32x4*)(wtab + 32 * ks + 8 * q + 4), d = *(const LAS f32x4*)(wtab + 128 + 32 * ks + 8 * q), e = *(const LAS f32x4*)(wtab + 128 + 32 * ks + 8 * q + 4);
            wf[ks][0] = a.x; wf[ks][1] = a.y; wf[ks][2] = a.z; wf[ks][3] = a.w; wf[ks][4] = c.x; wf[ks][5] = c.y; wf[ks][6] = c.z; wf[ks][7] = c.w;
            wb[ks][0] = d.x; wb[ks][1] = d.y; wb[ks][2] = d.z; wb[ks][3] = d.w; wb[ks][4] = e.x; wb[ks][5] = e.y; wb[ks][6] = e.z; wb[ks][7] = e.w; }
        float* So = SST + ((size_t)((b * NCC + cc) * 2) * 16 + head) * 8192;
        const bf16_t* bbase = BMT + ((size_t)b * 256 + g * 128 + l15) * TOKS + tokb + 8 * q;
        u32x4 bw[4], bn[4];
#pragma unroll
        for (int ks = 0; ks < 4; ++ks) bw[ks] = *(const u32x4*)(bbase + 32 * ks);
#pragma unroll 1
        for (int nt = 0; nt < 8; ++nt) {
            if (nt < 7) {
#pragma unroll
                for (int ks = 0; ks < 4; ++ks) bn[ks] = *(const u32x4*)(bbase + (size_t)16 * (nt + 1) * TOKS + 32 * ks);
            }
            f32x4 af[4], ab[4];
#pragma unroll
            for (int pt = 0; pt < 4; ++pt) { af[pt] = (f32x4){0.f, 0.f, 0.f, 0.f}; ab[pt] = af[pt]; }
#pragma unroll
            for (int ks = 0; ks < 4; ++ks) {
                const float bv[8] = {bflo(bw[ks].x), bfhi(bw[ks].x), bflo(bw[ks].y), bfhi(bw[ks].y), bflo(bw[ks].z), bfhi(bw[ks].z), bflo(bw[ks].w), bfhi(bw[ks].w)};
                const u32x4 ff = {cvt_pk_bf16(bv[0] * wf[ks][0], bv[1] * wf[ks][1]), cvt_pk_bf16(bv[2] * wf[ks][2], bv[3] * wf[ks][3]), cvt_pk_bf16(bv[4] * wf[ks][4], bv[5] * wf[ks][5]), cvt_pk_bf16(bv[6] * wf[ks][6], bv[7] * wf[ks][7])};
                const u32x4 fb = {cvt_pk_bf16(bv[0] * wb[ks][0], bv[1] * wb[ks][1]), cvt_pk_bf16(bv[2] * wb[ks][2], bv[3] * wb[ks][3]), cvt_pk_bf16(bv[4] * wb[ks][4], bv[5] * wb[ks][5]), cvt_pk_bf16(bv[6] * wb[ks][6], bv[7] * wb[ks][7])};
                const bf16x8 frf = __builtin_bit_cast(bf16x8, ff), frb = __builtin_bit_cast(bf16x8, fb);
#pragma unroll
                for (int pt = 0; pt < 4; ++pt) { af[pt] = __builtin_amdgcn_mfma_f32_16x16x32_bf16(xa[pt][ks], frf, af[pt], 0, 0, 0); ab[pt] = __builtin_amdgcn_mfma_f32_16x16x32_bf16(xa[pt][ks], frb, ab[pt], 0, 0, 0); }
            }
#pragma unroll
            for (int pt = 0; pt < 4; ++pt)
#pragma unroll
                for (int r = 0; r < 4; ++r) { const int pp = 16 * pt + 4 * q + r, n = 16 * nt + l15; So[(size_t)pp * 128 + n] = af[pt][r]; So[(size_t)16 * 8192 + (size_t)pp * 128 + n] = ab[pt][r]; }
#pragma unroll
            for (int ks = 0; ks < 4; ++ks) bw[ks] = bn[ks];
        }
        asm volatile("s_waitcnt lgkmcnt(0)" ::: "memory");
    }
}
__device__ __forceinline__ void ph_scan(Frame& F) {
    PHASE_IDS();
    const float* SST = WSP(float, WS_SST); const float* DEC = WSP(float, WS_DEC); bf16_t* HIN = WSP(bf16_t, WS_HIN);
    const int idx = vcu_ * NTHR + tid;
    if (idx < 2 * 2 * 16 * 2048) {
        const int e4 = idx & 2047, head = (idx >> 11) & 15, dir = (idx >> 15) & 1, b = idx >> 16;
        f32x4 h = {0.f, 0.f, 0.f, 0.f};
#pragma unroll 1
        for (int q0 = 0; q0 < NCC; q0 += 17) {
            f32x4 sv[17]; float dv[17];
#pragma unroll
            for (int k = 0; k < 17; ++k) { const int qq = q0 + k; const int cc = dir == 0 ? qq : (qq == 0 ? 1 : (qq == 1 ? 0 : 35 - qq));
                const size_t o = ((size_t)((b * NCC + cc) * 2 + dir) * 16 + head) * 8192 + e4 * 4;
                sv[k] = *(const f32x4*)(SST + o); dv[k] = DEC[(size_t)(b * NCC + cc) * 32 + dir * 16 + head]; }
            asm volatile("" ::: "memory");
#pragma unroll
            for (int k = 0; k < 17; ++k) { const int qq = q0 + k; const int cc = dir == 0 ? qq : (qq == 0 ? 1 : (qq == 1 ? 0 : 35 - qq));
                const size_t o = ((size_t)((b * NCC + cc) * 2 + dir) * 16 + head) * 8192 + e4 * 4;
                *(u32x2*)(HIN + o) = (u32x2){cvt_pk_bf16(h.x, h.y), cvt_pk_bf16(h.z, h.w)};
                h = h * dv[k] + sv[k]; }
        }
    }
}
__device__ __forceinline__ void ph_ssd3(Frame& F, int j, int cc_lo) {
    PHASE_IDS();
    const float* DT = WSP(float, WS_DT); const float* DA = WSP(float, WS_DA); const bf16_t* XST = WSP(bf16_t, WS_XST); const bf16_t* XBC = WSP(bf16_t, WS_XBC);
    const bf16_t* HIN = WSP(bf16_t, WS_HIN); float* Y = WSP(float, WS_YF); const float* ssd_d = KA->in[18] + j * 16;
    LAS float* tab = (LAS float*)(F.lds + wave * 16384);
    const int l15 = lane & 15, q = lane >> 4, ncc = NCC - cc_lo;
    const int jrow = 8 * (l15 >> 2) + (l15 & 3);
    for (int job = gw; job < 2 * ncc * 32; job += NGW) {
        const int half = job & 1, head = (job >> 1) & 15, cc = cc_lo + (job >> 5) % ncc, b = job / (32 * ncc), g = head >> 3, row0 = chunk_row0(b, cc), tokb = cc * 128;
        { const int r = row0 + 2 * lane;
          const float af0 = DA[(size_t)r * 32 + head], af1 = DA[(size_t)(r + 1) * 32 + head], ab0 = DA[(size_t)r * 32 + 16 + head], ab1 = DA[(size_t)(r + 1) * 32 + 16 + head];
          float pf0, pf1, tf, pb0, pb1, tb; chunk_prefix(af0, af1, lane, pf0, pf1, tf); chunk_prefix(ab0, ab1, lane, pb0, pb1, tb);
          tab[2 * lane] = pf0; tab[2 * lane + 1] = pf1; tab[128 + 2 * lane] = tb - pb0 + ab0; tab[128 + 2 * lane + 1] = tb - pb1 + ab1;
          tab[256 + 2 * lane] = DT[(size_t)r * 32 + head]; tab[256 + 2 * lane + 1] = DT[(size_t)(r + 1) * 32 + head];
          tab[384 + 2 * lane] = DT[(size_t)r * 32 + 16 + head]; tab[384 + 2 * lane + 1] = DT[(size_t)(r + 1) * 32 + 16 + head]; }
        asm volatile("s_waitcnt lgkmcnt(0)" ::: "memory");
        const float dsk = ssd_d[head];
        const bf16_t* hin_f = HIN + ((size_t)((b * NCC + cc) * 2 + 0) * 16 + head) * 8192 + (size_t)l15 * 128 + 8 * q; const bf16_t* hin_b = hin_f + (size_t)16 * 8192;
        const bf16_t* xst = XST + ((size_t)b * 1024 + head * 64 + l15) * TOKS + tokb + 8 * q;
        const bf16_t* bmr = XBC + (size_t)(row0 + jrow) * 1536 + 1024 + g * 128 + 8 * q;
        const LAS float* tq = tab + 8 * q;
#pragma unroll 1
        for (int ip = 0; ip < 2; ++ip) {
            const int ib0 = half * 4 + ip * 2;
            const int i0 = 16 * ib0 + l15, i1 = i0 + 16;
            const float P0 = tab[i0], S0 = tab[128 + i0], P1 = tab[i1], S1 = tab[128 + i1];
            const bf16_t* crow0 = XBC + (size_t)(row0 + i0) * 1536 + 1280 + g * 128 + 8 * q; const bf16_t* crow1 = crow0 + (size_t)16 * 1536;
            bf16x8 cf0[4], cf1[4];
#pragma unroll
            for (int ks = 0; ks < 4; ++ks) { cf0[ks] = *(const bf16x8*)(crow0 + 32 * ks); cf1[ks] = *(const bf16x8*)(crow1 + 32 * ks); }
            f32x4 y0[4], y1[4];
#pragma unroll
            for (int pt = 0; pt < 4; ++pt) { y0[pt] = (f32x4){0.f, 0.f, 0.f, 0.f}; y1[pt] = y0[pt]; }
            const int dq = 8 * q - l15;
#pragma unroll 1
            for (int kk = 0; kk < 4; ++kk) {
                f32x4 ga0 = {0.f, 0.f, 0.f, 0.f}, gb0 = ga0, ga1 = ga0, gb1 = ga0;
                bf16x8 bfa[4], bfb[4], xfr[4];
#pragma unroll
                for (int ks = 0; ks < 4; ++ks) { bfa[ks] = *(const bf16x8*)(bmr + (size_t)(32 * kk) * 1536 + 32 * ks); bfb[ks] = *(const bf16x8*)(bmr + (size_t)(32 * kk + 4) * 1536 + 32 * ks); }
#pragma unroll
                for (int pt = 0; pt < 4; ++pt) xfr[pt] = *(const bf16x8*)(xst + (size_t)16 * pt * TOKS + 32 * kk);
#pragma unroll
                for (int ks = 0; ks < 4; ++ks) { const bf16x8 ba = bfa[ks], bb = bfb[ks];
                    ga0 = __builtin_amdgcn_mfma_f32_16x16x32_bf16(ba, cf0[ks], ga0, 0, 0, 0); gb0 = __builtin_amdgcn_mfma_f32_16x16x32_bf16(bb, cf0[ks], gb0, 0, 0, 0);
                    ga1 = __builtin_amdgcn_mfma_f32_16x16x32_bf16(ba, cf1[ks], ga1, 0, 0, 0); gb1 = __builtin_amdgcn_mfma_f32_16x16x32_bf16(bb, cf1[ks], gb1, 0, 0, 0); }
                const LAS float* tj = tq + 32 * kk;
                const f32x4 Pa = *(const LAS f32x4*)(tj), Pb = *(const LAS f32x4*)(tj + 4), Sa = *(const LAS f32x4*)(tj + 128), Sb = *(const LAS f32x4*)(tj + 132);
                const f32x4 fa = *(const LAS f32x4*)(tj + 256), fb = *(const LAS f32x4*)(tj + 260), ba2 = *(const LAS f32x4*)(tj + 384), bb2 = *(const LAS f32x4*)(tj + 388);
                const float Pj[8] = {Pa.x, Pa.y, Pa.z, Pa.w, Pb.x, Pb.y, Pb.z, Pb.w}, Sj[8] = {Sa.x, Sa.y, Sa.z, Sa.w, Sb.x, Sb.y, Sb.z, Sb.w};
                const float dfj[8] = {fa.x, fa.y, fa.z, fa.w, fb.x, fb.y, fb.z, fb.w}, dbj[8] = {ba2.x, ba2.y, ba2.z, ba2.w, bb2.x, bb2.y, bb2.z, bb2.w};
                const int dj0 = 32 * kk - 16 * ib0 + dq;
                float m0[8], m1[8];
#pragma unroll
                for (int e = 0; e < 8; ++e) { const int d0 = dj0 + e, d1 = d0 - 16;
                    const float g0v = e < 4 ? ga0[e & 3] : gb0[e & 3], g1v = e < 4 ? ga1[e & 3] : gb1[e & 3];
                    const float w0 = (d0 <= 0 ? __expf(fminf(P0 - Pj[e], 0.f)) * dfj[e] : 0.f) + (d0 >= 0 ? __expf(fminf(S0 - Sj[e], 0.f)) * dbj[e] : 0.f);
                    const float w1 = (d1 <= 0 ? __expf(fminf(P1 - Pj[e], 0.f)) * dfj[e] : 0.f) + (d1 >= 0 ? __expf(fminf(S1 - Sj[e], 0.f)) * dbj[e] : 0.f);
                    m0[e] = g0v * w0; m1[e] = g1v * w1; }
                const bf16x8 mf0 = __builtin_bit_cast(bf16x8, ((u32x4){cvt_pk_bf16(m0[0], m0[1]), cvt_pk_bf16(m0[2], m0[3]), cvt_pk_bf16(m0[4], m0[5]), cvt_pk_bf16(m0[6], m0[7])}));
                const bf16x8 mf1 = __builtin_bit_cast(bf16x8, ((u32x4){cvt_pk_bf16(m1[0], m1[1]), cvt_pk_bf16(m1[2], m1[3]), cvt_pk_bf16(m1[4], m1[5]), cvt_pk_bf16(m1[6], m1[7])}));
#pragma unroll
                for (int pt = 0; pt < 4; ++pt) { const bf16x8 xf = xfr[pt];
                    y0[pt] = __builtin_amdgcn_mfma_f32_16x16x32_bf16(xf, mf0, y0[pt], 0, 0, 0); y1[pt] = __builtin_amdgcn_mfma_f32_16x16x32_bf16(xf, mf1, y1[pt], 0, 0, 0); }
            }
            const float ef0 = __expf(P0), eb0 = __expf(S0), ef1 = __expf(P1), eb1 = __expf(S1);
#pragma unroll
            for (int pt = 0; pt < 4; ++pt) {
                f32x4 of0 = {0.f, 0.f, 0.f, 0.f}, ob0 = of0, of1 = of0, ob1 = of0;
#pragma unroll
                for (int ks = 0; ks < 4; ++ks) { const bf16x8 hf = *(const bf16x8*)(hin_f + (size_t)16 * pt * 128 + 32 * ks), hb = *(const bf16x8*)(hin_b + (size_t)16 * pt * 128 + 32 * ks);
                    of0 = __builtin_amdgcn_mfma_f32_16x16x32_bf16(hf, cf0[ks], of0, 0, 0, 0); ob0 = __builtin_amdgcn_mfma_f32_16x16x32_bf16(hb, cf0[ks], ob0, 0, 0, 0);
                    of1 = __builtin_amdgcn_mfma_f32_16x16x32_bf16(hf, cf1[ks], of1, 0, 0, 0); ob1 = __builtin_amdgcn_mfma_f32_16x16x32_bf16(hb, cf1[ks], ob1, 0, 0, 0); }
                const u32x2 xw0 = *(const u32x2*)(XBC + (size_t)(row0 + i0) * 1536 + head * 64 + 16 * pt + 4 * q), xw1 = *(const u32x2*)(XBC + (size_t)(row0 + i1) * 1536 + head * 64 + 16 * pt + 4 * q);
                f32x4 v0 = y0[pt] + of0 * ef0 + ob0 * eb0, v1 = y1[pt] + of1 * ef1 + ob1 * eb1;
                v0.x += dsk * bflo(xw0.x); v0.y += dsk * bfhi(xw0.x); v0.z += dsk * bflo(xw0.y); v0.w += dsk * bfhi(xw0.y);
                v1.x += dsk * bflo(xw1.x); v1.y += dsk * bfhi(xw1.x); v1.z += dsk * bflo(xw1.y); v1.w += dsk * bfhi(xw1.y);
                *(f32x4*)(Y + (size_t)(row0 + i0) * 1024 + head * 64 + 16 * pt + 4 * q) = v0;
                *(f32x4*)(Y + (size_t)(row0 + i1) * 1024 + head * 64 + 16 * pt + 4 * q) = v1;
            }
        }
        asm volatile("s_waitcnt lgkmcnt(0)" ::: "memory");
    }
}

__device__ __forceinline__ unsigned w4(const u32x4& v, int i) { return i == 0 ? v.x : (i == 1 ? v.y : (i == 2 ? v.z : v.w)); }
__device__ __forceinline__ void ph_vt(Frame& F) {
    PHASE_IDS();
    const bf16_t* PROJ = WSP(bf16_t, WS_PROJ); bf16_t* VT = WSP(bf16_t, WS_VT);
    for (int wit = gw; wit < (MT / 64) * 16; wit += NGW) {
        const int rg = (wit >> 4) * 8 + (lane & 7), ch = (wit & 15) * 64 + (lane >> 3) * 8, row0 = rg * 8;
        int b, tok0; if (row0 < ML) { b = row0 >> 12; tok0 = row0 & 4095; } else { const int rr = row0 - ML; b = rr >> 8; tok0 = 4096 + (rr & 255); }
        u32x4 in[8];
#pragma unroll
        for (int r = 0; r < 8; ++r) in[r] = MK_NT_X ? __builtin_nontemporal_load((const u32x4*)(PROJ + (size_t)(row0 + r) * NPJ + 2048 + ch)) : *(const u32x4*)(PROJ + (size_t)(row0 + r) * NPJ + 2048 + ch);
        bf16_t* dst = VT + ((size_t)(b * 8 + (ch >> 7)) * 128 + (ch & 127)) * VTP + tok0;
#pragma unroll
        for (int e = 0; e < 8; ++e) { const unsigned sel = (e & 1) ? 0x07060302u : 0x05040100u; const int w = e >> 1;
            const u32x4 o = {__builtin_amdgcn_perm(w4(in[1], w), w4(in[0], w), sel), __builtin_amdgcn_perm(w4(in[3], w), w4(in[2], w), sel), __builtin_amdgcn_perm(w4(in[5], w), w4(in[4], w), sel), __builtin_amdgcn_perm(w4(in[7], w), w4(in[6], w), sel)};
            *(u32x4*)(dst + (size_t)e * VTP) = o; }
    }
}
__device__ __forceinline__ void attn_job(KArgsPtr KA, Frame& F, int job, int j, int lane_, int wave) {
    int lane = lane_; asm volatile("" : "+v"(lane));
    const bf16_t* QP = WSP(bf16_t, WS_QP); const bf16_t* QR = WSP(bf16_t, WS_QR); const bf16_t* KR = WSP(bf16_t, WS_KR); const bf16_t* VT = WSP(bf16_t, WS_VT);
    const float* rpb = KA->in[13] + j * 8 * 15 * 31; bf16_t* MIX = WSP(bf16_t, WS_MIX);
    const int l15 = lane & 15, qq = lane >> 4;
    const float SC = 0.08838834764831845f * LOG2E;
    const bool lat = job < 2048;
    int b, h, qrowA, qrowB, rA = 0, cg = 0;
    if (lat) { cg = job & 3; rA = ((job >> 2) & 31) * 2; h = (job >> 7) & 7; b = job >> 10; qrowA = b * 4096 + rA * 64 + 16 * cg + l15; qrowB = qrowA + 64; }
    else { const int jj = job - 2048; h = (jj >> 3) & 7; b = jj >> 6; qrowA = ML + b * 256 + 32 * (jj & 7) + l15; qrowB = qrowA + 16; }
    LAS float* btab = (LAS float*)(F.lds + wave * 16384 + 2048);
    if (lat) {
        float bt[8];
#pragma unroll
        for (int i = 0; i < 8; ++i) { const int idx = lane + 64 * i; bt[i] = rpb[h * 465 + (idx < 465 ? idx : 464)]; }
        asm volatile("" ::: "memory");
#pragma unroll
        for (int i = 0; i < 8; ++i) { const int idx = lane + 64 * i; if (idx < 465) btab[idx] = bt[i] * LOG2E; }
    }
    int r0A = rA - 4; r0A = r0A < 0 ? 0 : (r0A > 56 ? 56 : r0A);
    int r0B = rA - 3; r0B = r0B < 0 ? 0 : (r0B > 56 ? 56 : r0B);
    const int nwin = lat ? (r0B + 8 - r0A) : 0;
    const int s0 = cg == 0 ? 0 : (cg == 1 ? 8 : (cg == 2 ? 24 : 32)), qcol = 16 * cg + l15;
    int c0 = qcol - 8; c0 = c0 < 0 ? 0 : (c0 > 48 ? 48 : c0);
    f32x4 oA[8], oB[8];
#pragma unroll
    for (int dt = 0; dt < 8; ++dt) { oA[dt] = (f32x4){0.f, 0.f, 0.f, 0.f}; oB[dt] = oA[dt]; }
    float mA = -INFINITY, lA = 0.f, mB = -INFINITY, lB = 0.f;
    const int krl = 8 * (l15 >> 2) + (l15 & 3);
    const bf16_t* vt = VT + (size_t)(b * 8 + h) * 128 * VTP + (size_t)l15 * VTP + 8 * qq;
    const bf16_t* kwin = KR + (size_t)(b * 4096 + r0A * 64 + s0 + krl) * KRP + h * 128 + 8 * qq;
    const bf16_t* kctx = KR + (size_t)(ML + b * 256 + krl) * KRP + h * 128 + 8 * qq;
    bf16x8 qA[4], qB[4];
    const size_t qoa = (size_t)qrowA * 1024 + h * 128 + 8 * qq, qob = (size_t)qrowB * 1024 + h * 128 + 8 * qq;
#pragma unroll
    for (int ks = 0; ks < 4; ++ks) { qA[ks] = *(const bf16x8*)(QR + qoa + 32 * ks); qB[ks] = *(const bf16x8*)(QR + qob + 32 * ks); }
    asm volatile("s_waitcnt lgkmcnt(0)" ::: "memory");
    const int nstep = nwin + 8;
#pragma unroll 1
    for (int step = 0; step < nstep; ++step) {
        const bool win = step < nwin;
        if (step == nwin) {
#pragma unroll
            for (int ks = 0; ks < 4; ++ks) { qA[ks] = *(const bf16x8*)(QP + qoa + 32 * ks); qB[ks] = *(const bf16x8*)(QP + qob + 32 * ks); }
        }
        const bf16_t* kp = win ? kwin + (size_t)step * 64 * KRP : kctx + (size_t)(step - nwin) * 32 * KRP;
        bf16x8 kc[8];
#pragma unroll
        for (int ks = 0; ks < 4; ++ks) { kc[ks] = *(const bf16x8*)(kp + 32 * ks); kc[4 + ks] = *(const bf16x8*)(kp + 4 * KRP + 32 * ks); }
        const bf16_t* vb = vt + (win ? (r0A + step) * 64 + s0 : 4096 + 32 * (step - nwin));
        bf16x8 vx[8];
#pragma unroll
        for (int dt = 0; dt < 8; ++dt) vx[dt] = *(const bf16x8*)(vb + (size_t)16 * dt * VTP);
        f32x4 sa0 = {0.f, 0.f, 0.f, 0.f}, sa1 = sa0, sb0 = sa0, sb1 = sa0;
#pragma unroll
        for (int ks = 0; ks < 4; ++ks) { sa0 = __builtin_amdgcn_mfma_f32_16x16x32_bf16(kc[ks], qA[ks], sa0, 0, 0, 0); sa1 = __builtin_amdgcn_mfma_f32_16x16x32_bf16(kc[4 + ks], qA[ks], sa1, 0, 0, 0);
                                         sb0 = __builtin_amdgcn_mfma_f32_16x16x32_bf16(kc[ks], qB[ks], sb0, 0, 0, 0); sb1 = __builtin_amdgcn_mfma_f32_16x16x32_bf16(kc[4 + ks], qB[ks], sb1, 0, 0, 0); }
        float svA[8], svB[8];
        if (win) {
            const int krow = r0A + step;
            const bool rowA = krow < r0A + 8, rowB = krow >= r0B;
            const LAS float* browA = btab + (krow - rA + 7) * 31 + 15; const LAS float* browB = browA - 31;
            float bs[8];
#pragma unroll
            for (int e = 0; e < 8; ++e) { int dc = s0 + 8 * qq + e - qcol; dc = dc < -15 ? -15 : (dc > 15 ? 15 : dc); bs[e] = rowA ? browA[dc] : 0.f; }
#pragma unroll
            for (int e = 0; e < 8; ++e) { const int kcn = s0 + 8 * qq + e; const bool okc = kcn >= c0 && kcn < c0 + 16;
                svA[e] = (okc && rowA) ? (e < 4 ? sa0[e & 3] : sa1[e & 3]) * SC + bs[e] : -INFINITY; }
#pragma unroll
            for (int e = 0; e < 8; ++e) { int dc = s0 + 8 * qq + e - qcol; dc = dc < -15 ? -15 : (dc > 15 ? 15 : dc); bs[e] = rowB ? browB[dc] : 0.f; }
#pragma unroll
            for (int e = 0; e < 8; ++e) { const int kcn = s0 + 8 * qq + e; const bool okc = kcn >= c0 && kcn < c0 + 16;
                svB[e] = (okc && rowB) ? (e < 4 ? sb0[e & 3] : sb1[e & 3]) * SC + bs[e] : -INFINITY; }
        } else {
#pragma unroll
            for (int e = 0; e < 8; ++e) { svA[e] = (e < 4 ? sa0[e & 3] : sa1[e & 3]) * SC; svB[e] = (e < 4 ? sb0[e & 3] : sb1[e & 3]) * SC; }
        }
#define ATT_SOFTMAX(sv, m, l, o) do { \
        float tmax = fmaxf(fmaxf(fmaxf(sv[0], sv[1]), fmaxf(sv[2], sv[3])), fmaxf(fmaxf(sv[4], sv[5]), fmaxf(sv[6], sv[7]))); \
        tmax = fmaxf(tmax, shx(tmax, 16, lane)); tmax = fmaxf(tmax, shx(tmax, 32, lane)); \
        const float mn = fmaxf(m, tmax), mref = mn == -INFINITY ? 0.f : mn, alpha = __builtin_amdgcn_exp2f(m - mref); m = mn; \
        float pe[8]; float ps = 0.f; \
        _Pragma("unroll") for (int e = 0; e < 8; ++e) { pe[e] = __builtin_amdgcn_exp2f(sv[e] - mref); ps += pe[e]; } \
        l = l * alpha + ps; \
        const bf16x8 pfrag = __builtin_bit_cast(bf16x8, ((u32x4){cvt_pk_bf16(pe[0], pe[1]), cvt_pk_bf16(pe[2], pe[3]), cvt_pk_bf16(pe[4], pe[5]), cvt_pk_bf16(pe[6], pe[7])})); \
        _Pragma("unroll") for (int dt = 0; dt < 8; ++dt) { o[dt] = o[dt] * alpha; o[dt] = __builtin_amdgcn_mfma_f32_16x16x32_bf16(vx[dt], pfrag, o[dt], 0, 0, 0); } } while (0)
        ATT_SOFTMAX(svA, mA, lA, oA);
        ATT_SOFTMAX(svB, mB, lB, oB);
#undef ATT_SOFTMAX
    }
    lA += shx(lA, 16, lane); lA += shx(lA, 32, lane); lB += shx(lB, 16, lane); lB += shx(lB, 32, lane);
    const float invA = 1.0f / lA, invB = 1.0f / lB;
#pragma unroll
    for (int dt = 0; dt < 8; ++dt) { const f32x4 va = oA[dt] * invA, vb2 = oB[dt] * invB;
        *(u32x2*)(MIX + (size_t)qrowA * D + h * 128 + 16 * dt + 4 * qq) = (u32x2){cvt_pk_bf16(va.x, va.y), cvt_pk_bf16(va.z, va.w)};
        *(u32x2*)(MIX + (size_t)qrowB * D + h * 128 + 16 * dt + 4 * qq) = (u32x2){cvt_pk_bf16(vb2.x, vb2.y), cvt_pk_bf16(vb2.z, vb2.w)}; }
    asm volatile("s_waitcnt lgkmcnt(0)" ::: "memory");
}
__device__ __forceinline__ void ph_ssd1_attn(Frame& F, int j, int with_ctxq, int sub) {
    PHASE_IDS();
    const int n1 = 2 * NCC * 16, njobs = sub == 1 ? n1 : n1 + 2048 + (with_ctxq ? 128 : 0);
    for (int t = gw + (sub == 2 ? n1 : 0); t < njobs; t += NGW) {
        if (t < n1) ssd1_job(KA, F, t, lane, wave);
        else attn_job(KA, F, t - n1, j, lane, wave);
    }
}
__device__ __forceinline__ void ph_attn_naive(Frame& F, int j, int nrows) {
    PHASE_IDS();
    const bf16_t* QP = WSP(bf16_t, WS_QP); const bf16_t* QR = WSP(bf16_t, WS_QR); const bf16_t* KR = WSP(bf16_t, WS_KR); const bf16_t* PROJ = WSP(bf16_t, WS_PROJ);
    const float* rpb = KA->in[13] + j * 8 * 15 * 31; bf16_t* MIX = WSP(bf16_t, WS_MIX);
    LAS float* sq = (LAS float*)(F.lds + wave * 16384);
    LAS float* sp = sq + 256;
    LAS int* skey = (LAS int*)(sp + 384);
    for (int it = gw; it < nrows * 8; it += NGW) {
        const int row = it >> 3, h = it & 7;
        sq[lane] = bf2f(QR[(size_t)row * 1024 + h * 128 + lane]); sq[lane + 64] = bf2f(QR[(size_t)row * 1024 + h * 128 + lane + 64]);
        sq[128 + lane] = bf2f(QP[(size_t)row * 1024 + h * 128 + lane]); sq[128 + lane + 64] = bf2f(QP[(size_t)row * 1024 + h * 128 + lane + 64]);
        asm volatile("s_waitcnt lgkmcnt(0)" ::: "memory");
        const bool lat = row < ML; const int b = lat ? (row >> 12) : ((row - ML) >> 8);
        const int nk = lat ? 384 : 256; const int t = row & 4095, r = t >> 6, qc = t & 63;
        int r0 = r - 4; r0 = r0 < 0 ? 0 : (r0 > 56 ? 56 : r0);
        int c0 = qc - 8; c0 = c0 < 0 ? 0 : (c0 > 48 ? 48 : c0);
        float mx = -INFINITY;
        for (int i = lane; i < nk; i += 64) {
            int key; float bias = 0.f; int qsel = 128;
            if (lat && i < 128) { const int kr = r0 + (i >> 4), kc = c0 + (i & 15); key = b * 4096 + kr * 64 + kc; int dc = kc - qc; dc = dc < -15 ? -15 : (dc > 15 ? 15 : dc);
                bias = rpb[(h * 15 + (kr - r + 7)) * 31 + dc + 15]; qsel = 0; }
            else key = ML + b * 256 + (lat ? i - 128 : i);
            const u32x4* kp = (const u32x4*)(KR + (size_t)key * 1024 + h * 128); float d = 0.f;
#pragma unroll 4
            for (int e = 0; e < 16; ++e) { const u32x4 w = kp[e]; const LAS float* q = sq + qsel + e * 8;
                d += q[0] * bflo(w.x) + q[1] * bfhi(w.x) + q[2] * bflo(w.y) + q[3] * bfhi(w.y) + q[4] * bflo(w.z) + q[5] * bfhi(w.z) + q[6] * bflo(w.w) + q[7] * bfhi(w.w); }
            const float s = d * 0.08838834764831845f + bias; sp[i] = s; skey[i] = key; mx = fmaxf(mx, s);
        }
        mx = wave_max(mx, lane);
        float sum = 0.f;
        for (int i = lane; i < nk; i += 64) { const float e = __expf(sp[i] - mx); sp[i] = e; sum += e; }
        sum = wave_sum(sum, lane);
        asm volatile("s_waitcnt lgkmcnt(0)" ::: "memory");
        float o0 = 0.f, o1 = 0.f;
        for (int i = 0; i < nk; ++i) { const bf16_t* vp = PROJ + (size_t)skey[i] * NPJ + 2048 + h * 128; const float pv = sp[i]; o0 += pv * bf2f(vp[lane]); o1 += pv * bf2f(vp[lane + 64]); }
        const float inv = 1.f / sum;
        MIX[(size_t)row * D + h * 128 + lane] = f2bf(o0 * inv); MIX[(size_t)row * D + h * 128 + lane + 64] = f2bf(o1 * inv);
        asm volatile("s_waitcnt lgkmcnt(0)" ::: "memory");
    }
}
__device__ __forceinline__ void ph_gated(Frame& F, int j, int nrows) {
    PHASE_IDS();
    const float* YF = WSP(float, WS_YF); const bf16_t* PROJ = WSP(bf16_t, WS_PROJ);
    const float* g = KA->in[19] + j * 1024; bf16_t* MIX = WSP(bf16_t, WS_MIX);
    for (int it = gw; it < nrows * 2; it += NGW) {
        const int row = it >> 1, grp = it & 1, ch = grp * 512 + lane * 8;
        const f32x4 yf0 = *(const f32x4*)(YF + (size_t)row * 1024 + ch), yf1 = *(const f32x4*)(YF + (size_t)row * 1024 + ch + 4);
        const u32x4 zw = *(const u32x4*)(PROJ + (size_t)row * NPJ + 3072 + ch);
        const float zs[8] = {bflo(zw.x), bfhi(zw.x), bflo(zw.y), bfhi(zw.y), bflo(zw.z), bfhi(zw.z), bflo(zw.w), bfhi(zw.w)};
        const float ys[8] = {yf0.x, yf0.y, yf0.z, yf0.w, yf1.x, yf1.y, yf1.z, yf1.w};
        float yz[8]; float ss = 0.f;
#pragma unroll
        for (int e = 0; e < 8; ++e) { yz[e] = ys[e] * fast_silu(zs[e]); ss += yz[e] * yz[e]; }
        const float r = 1.0f / sqrtf(wave_sum(ss, lane) * (1.f / 512.f) + EPS);
        const f32x4 g0 = *(const f32x4*)(g + ch), g1 = *(const f32x4*)(g + ch + 4);
        u32x4 o; o.x = cvt_pk_bf16(yz[0] * r * g0.x, yz[1] * r * g0.y); o.y = cvt_pk_bf16(yz[2] * r * g0.z, yz[3] * r * g0.w); o.z = cvt_pk_bf16(yz[4] * r * g1.x, yz[5] * r * g1.y); o.w = cvt_pk_bf16(yz[6] * r * g1.z, yz[7] * r * g1.w);
        *(u32x4*)(MIX + (size_t)row * D + 1024 + ch) = o;
    }
}

constexpr int PPL = 14, N_PHASES = 1 + 4 * PPL;

#ifndef MK_CTX_SPLIT
#define MK_CTX_SPLIT 1
#endif
#define MK_GEMM(EpiT, Eobj, Aptr, lda_, Bptr, ldb_, K_, M_, N_, Z_, zdiv_, zA1_, zA2_, zB1_, zB2_, cid_) do { \
    pg8::Gemm g_{(const bf16_t*)(Aptr), (const bf16_t*)(Bptr), (lda_), (ldb_), (K_), (zdiv_), (long)(zA1_), (long)(zA2_), (long)(zB1_), (long)(zB2_), (long)256 * (lda_), (long)256 * (ldb_), 127, 127}; \
    pg8::Order S_; S_.init((M_), (N_), (Z_), G_, (cid_)); \
    pg8::gemm_phase<EpiT, (MK_ALIGN != 0)>(F.lds, g_, S_, Eobj); } while (0)

#define MK_GEMM8(EpiT, Eobj, Aptr, lda_, Bptr, ldb_, K_, M_, N_, Z_, zA1_, zB1_, sclB_, sclA_, cid_) do { \
    pg8::Gemm g_{(const bf16_t*)(Aptr), (const bf16_t*)(Bptr), (lda_), (ldb_), (K_), 1, (long)(zA1_), 0, (long)(zB1_), 0, (long)256 * (lda_), (long)256 * (ldb_), (sclB_), (sclA_)}; \
    pg8::Order S_; S_.init((M_), (N_), (Z_), G_, (cid_)); \
    pg8::gemm_phase<EpiT, (MK_ALIGN != 0), true>(F.lds, g_, S_, Eobj); } while (0)
#define MK_GEMM_TS(EpiT, Eobj, Aptr, lda_, Bptr, ldb_, tsB_, K_, M_, N_, Z_, zdiv_, zA1_, zA2_, zB1_, zB2_, cid_) do { \
    pg8::Gemm g_{(const bf16_t*)(Aptr), (const bf16_t*)(Bptr), (lda_), (ldb_), (K_), (zdiv_), (long)(zA1_), (long)(zA2_), (long)(zB1_), (long)(zB2_), (long)256 * (lda_), (long)(tsB_), 127, 127}; \
    pg8::Order S_; S_.init((M_), (N_), (Z_), G_, (cid_)); \
    pg8::gemm_phase<EpiT, (MK_ALIGN != 0)>(F.lds, g_, S_, Eobj); } while (0)

__global__ void __launch_bounds__(NTHR, 2) mk_fwd(Args args) {
    extern __shared__ __attribute__((aligned(16))) unsigned char lds_raw[];
    Frame F;
    F.lds = (LAS unsigned char*)lds_raw;
    const int tid0 = threadIdx.x;
    volatile LAS unsigned* MISC = (volatile LAS unsigned*)(F.lds + MISC_OFF);
    for (int u = tid0; u < (LDS_BYTES - RING_BYTES) / 4; u += NTHR) ((LAS unsigned*)(F.lds + RING_BYTES))[u] = 0u;
    __syncthreads();
    if (args.ph_hi - args.ph_lo > 1) (void)xcd_barrier_post((unsigned*)(args.ws + WS_CTL) + CW_BAR, MISC + 8);
#define IN(k) (KA->ph_lo <= (k) && (k) < KA->ph_hi)
#define SEAM(k) do { KA_LOAD(); if (KA->ph_lo <= (k) && (k) + 1 < KA->ph_hi) { XcdBarrier bar_; bar_.bar = WSP(unsigned, WS_CTL) + CW_BAR; bar_.x = xb_xcc_id(); bar_.st = (volatile LAS unsigned*)(F.lds + MISC_OFF) + 8; xcd_barrier(bar_); } } while (0)
#ifndef MK_DUP
#define MK_DUP 0
#endif
#ifndef MK_DUP_LATONLY
#define MK_DUP_LATONLY 0
#endif
#ifndef MK_PROBE_SUB
#define MK_PROBE_SUB 0
#endif
#ifndef MK_PROBE_K
#define MK_PROBE_K DFF
#endif
#ifndef MK_PROBE_TS0
#define MK_PROBE_TS0 0
#endif
#ifndef MK_PROBE_NULLEPI
#define MK_PROBE_NULLEPI 0
#endif
#ifndef MK_FUSED_NORM
#define MK_FUSED_NORM 0
#endif
#ifndef MK_PROBE_COLDW
#define MK_PROBE_COLDW 0
#endif
#ifndef MK_ALIGN
#define MK_ALIGN 1
#endif
#ifndef MK_DUPN
#define MK_DUPN 2
#endif
#define NREP(bit) (1 + (((MK_DUP) >> (bit)) & 1) * (MK_DUPN - 1))
#define REP(bit) for (int rep_ = 0; rep_ < NREP(bit); ++rep_)
#define SEAMR(k, bit) do { KA_LOAD(); if (KA->ph_lo <= (k) && ((k) + 1 < KA->ph_hi || rep_ + 1 < NREP(bit))) { XcdBarrier bar_; bar_.bar = WSP(unsigned, WS_CTL) + CW_BAR; bar_.x = xb_xcc_id(); bar_.st = (volatile LAS unsigned*)(F.lds + MISC_OFF) + 8; xcd_barrier(bar_); } } while (0)
#define XR_ WSP(float, WS_XR)
#define MODL_ (WSP(float, WS_MOD) + (size_t)layer * 3 * NMOD)
#define NORMG_ (KA->in[6] + layer * 3 * D)
#define CID_ ((int)blockIdx.x)
#define CIDR_ ((int)gridDim.x - 1 - (int)blockIdx.x)
#define G_ ((int)gridDim.x)

    REP(0) {
    { KA_LOAD(); if (IN(0)) { ph_mod(F); __syncthreads(); ph_weights(F); ph_tables(F); } }
    SEAMR(0, 0); }

#ifdef MK_PROBE_BAR
    for (int eb = 0; eb < MK_PROBE_BAR; ++eb) { KA_LOAD(); XcdBarrier bar_; bar_.bar = WSP(unsigned, WS_CTL) + CW_BAR; bar_.x = xb_xcc_id(); bar_.st = (volatile LAS unsigned*)(F.lds + MISC_OFF) + 8; xcd_barrier(bar_); }
#endif
    for (int layer = 0; layer < 4; ++layer) {
        const int pb = 1 + layer * PPL, j = layer >> 1;
        const bool even = (layer & 1) == 0, use_ctx = layer <= 2, ctx_out = layer < 2;
        const int rows_n = use_ctx ? MT : ML, rows_m = ctx_out ? MT : ML;
        const bool fusedn = MK_FUSED_NORM && (int)gridDim.x == 256;
        if (!(fusedn && layer > 0 && rows_n == ML))
        REP(1) {
        { KA_LOAD(); if (IN(pb + 0)) { KA_LOAD(); ph_norm(F, NORMG_, MODL_, 0, (fusedn && layer > 0) ? ML : 0, rows_n, (rep_ + 1 < NREP(1)) ? 0 : ((layer == 1 || layer == 2) ? 11 : 0), layer == 0 ? KA->in[0] : XR_, layer == 0 ? KA->in[2] : XR_ + (size_t)ML * D); } }
        SEAMR(pb + 0, 1); }
        REP(2) {
        { KA_LOAD(); if (IN(pb + 1)) { KA_LOAD(); EpiSwiglu E{WSP(bf16_t, WS_H)};
            if (MK_PROBE_NULLEPI && rep_ + 1 < NREP(2)) { EpiNull En; MK_GEMM(EpiNull, En, WSP(bf16_t, WS_XN), D, WSP(bf16_t, WS_W13) + (size_t)(layer * 2) * 2 * DFF * D, D, D, rows_n, 2 * DFF, 1, 1, 0, 0, 0, 0, CID_); }
            else if ((MK_F8_MASK >> (layer * 2)) & 1) { EpiSwiglu8 E8{WSP(unsigned char, WS_H)}; MK_GEMM(EpiSwiglu8, E8, WSP(bf16_t, WS_XN), D, WSP(bf16_t, WS_W13) + (size_t)(layer * 2) * 2 * DFF * D, D, D, rows_n, 2 * DFF, 1, 1, 0, 0, 0, 0, CID_); }
            else MK_GEMM(EpiSwiglu, E, WSP(bf16_t, WS_XN), D, WSP(bf16_t, WS_W13) + (size_t)(layer * 2 + ((MK_PROBE_COLDW && rep_ + 1 < NREP(2)) ? ((layer + 2) % 4) * 2 - layer * 2 + 1 : 0)) * 2 * DFF * D, D, D, rows_n, 2 * DFF, 1, 1, 0, 0, 0, 0, CID_); } }
        SEAMR(pb + 1, 2); }
        REP(14) { const float gsm_ = (rep_ + 1 < NREP(14)) ? 0.f : 1.f;
        { KA_LOAD(); if (IN(pb + 2)) {
            if (use_ctx && (!MK_DUP_LATONLY || gsm_ != 0.f)) { KA_LOAD(); EpiPart E{WSP(float, WS_PART), MODL_ + 2 * D, 0.5f * gsm_};
              if ((MK_F8_MASK >> (layer * 2)) & 1) MK_GEMM8(EpiPart, E, WSP(unsigned char, WS_H) + (size_t)ML * DFF, DFF / 2, WSP(unsigned char, WS_W28) + (size_t)(layer * 2) * D * DFF, DFF / 2, 256, MC, D, 11, 256, 256, 127 - F8_SW, 127 - F8_SA, CIDR_);
              else MK_GEMM(EpiPart, E, WSP(bf16_t, WS_H) + (size_t)ML * HP, HP, WSP(bf16_t, WS_W2) + (size_t)(layer * 2) * D * HP, HP, 512, MC, D, 11, 1, 512, 0, 512, 0, CIDR_); }
                        { KA_LOAD(); EpiResid<false> E{layer == 0 ? KA->in[0] : XR_, XR_, MODL_ + 2 * D, 0.5f * gsm_, 0, fusedn ? 1 : 0};
              if (MK_PROBE_TS0 && gsm_ == 0.f) { pg8::Gemm g_{MK_PROBE_TS0 == 2 ? WSP(bf16_t, WS_CTL + 262144) : WSP(bf16_t, WS_H), MK_PROBE_TS0 == 2 ? WSP(bf16_t, WS_CTL + 262144) : WSP(bf16_t, WS_W2) + (size_t)(layer * 2) * D * HP, MK_PROBE_TS0 == 2 ? 0 : HP, MK_PROBE_TS0 == 2 ? 0 : HP, MK_PROBE_K, 1, 0, 0, 0, 0, 0, 0, 127, 127}; pg8::Order S_; S_.init(ML, D, 1, G_, CID_); pg8::gemm_phase<EpiResid<false>, true>(F.lds, g_, S_, E); }
              else if ((MK_F8_MASK >> (layer * 2)) & 1) MK_GEMM8(EpiResid<false>, E, WSP(unsigned char, WS_H), DFF / 2, WSP(unsigned char, WS_W28) + (size_t)(layer * 2) * D * DFF, DFF / 2, DFF / 2, ML, D, 1, 0, 0, 127 - F8_SW, 127 - F8_SA, CID_);
              else MK_GEMM(EpiResid<false>, E, WSP(bf16_t, WS_H), HP, WSP(bf16_t, WS_W2) + (size_t)(layer * 2) * D * HP, HP, (gsm_ == 0.f ? MK_PROBE_K : DFF), ML, D, 1, 1, 0, 0, 0, 0, CID_); }
            if (fusedn && gsm_ != 0.f) { KA_LOAD(); panel_publish(KA, layer * 3 + 1); }

            if (fusedn && gsm_ != 0.f) { KA_LOAD(); panel_norm(F, layer * 3 + 1, NORMG_ + D, MODL_, 3); }
        } }
        SEAMR(pb + 2, 14); }
        if (!(fusedn && rows_n == ML))
        REP(3) {
        { KA_LOAD(); if (IN(pb + 3)) { KA_LOAD(); ph_norm(F, NORMG_ + D, MODL_, 3, fusedn ? ML : 0, rows_n, (rep_ + 1 < NREP(3)) ? 0 : (use_ctx ? 11 : 0), XR_, layer == 0 ? KA->in[2] : XR_ + (size_t)ML * D); } }
        SEAMR(pb + 3, 3); }
        if (even) {
            REP(4) {
            { KA_LOAD(); if (IN(pb + 4)) { { KA_LOAD(); EpiStoreBf16 E{WSP(bf16_t, WS_PROJ), NPJ, 1.0f, 0};
                MK_GEMM(EpiStoreBf16, E, WSP(bf16_t, WS_XN), D, WSP(bf16_t, WS_WIN) + (size_t)j * NPJ * D, D, D, MT, NPJ, 1, 1, 0, 0, 0, 0, CID_); }
                } }
            SEAMR(pb + 4, 4); }
            REP(5) {
            { KA_LOAD(); if (IN(pb + 5)) { const int sub_ = (rep_ + 1 < NREP(5)) ? MK_PROBE_SUB : 0; if (sub_ == 0 || sub_ == 1) ph_dt(F, j); if (sub_ == 0 || sub_ == 2) ph_qknorm(F, j); if (sub_ == 0 || sub_ == 3) ph_conv2(F, j); if (sub_ == 0 || sub_ == 4) ph_vt(F); } }
            SEAMR(pb + 5, 5); }
            REP(6) {
            { KA_LOAD(); if (IN(pb + 6)) { ph_ssd1_attn(F, j, ctx_out ? 1 : 0, (rep_ + 1 < NREP(6)) ? MK_PROBE_SUB : 0); } }
            SEAMR(pb + 6, 6); }
            REP(7) {
            { KA_LOAD(); if (IN(pb + 7)) ph_scan(F); }
            SEAMR(pb + 7, 7); }
            REP(8) {
            { KA_LOAD(); if (IN(pb + 8)) ph_ssd3(F, j, ctx_out ? 0 : 2); }
            SEAMR(pb + 8, 8); }
            REP(9) {
            { KA_LOAD(); if (IN(pb + 9)) ph_gated(F, j, rows_m); }
            SEAMR(pb + 9, 9); }
        } else {
            REP(10) {
            { KA_LOAD(); if (IN(pb + 4)) {
                { KA_LOAD(); EpiF1b E{WSP(bf16_t, WS_BT2)};
                  MK_GEMM_TS(EpiF1b, E, WSP(bf16_t, WS_DFTC), 512, WSP(bf16_t, WS_XN), 16 * D, D, 512, 1024, SEQ, 8, 4, 0, 0, (long)SEQ * D, 512, CID_); }
                if (ctx_out) { KA_LOAD(); EpiF1 E{WSP(bf16_t, WS_BT2C), CTXL};
                  MK_GEMM(EpiF1, E, WSP(bf16_t, WS_DFTC), 512, WSP(bf16_t, WS_XN) + (size_t)ML * D, D, 512, 1024, CTXL, 8, 4, 0, 0, (long)CTXL * D, 512, CIDR_); }
            } }
            SEAMR(pb + 4, 10); }
            REP(11) {
            { KA_LOAD(); if (IN(pb + 5)) {
                { KA_LOAD(); EpiTw E{WSP(bf16_t, WS_TW)};
                  MK_GEMM(EpiTw, E, WSP(bf16_t, WS_F1MAT), 512, WSP(bf16_t, WS_BT2), 512, 512, 512, 16 * D, 2, 1, 0, 0, (long)D * 8192, 0, CID_); }
                if (ctx_out) { KA_LOAD(); EpiStoreBf16 E{WSP(bf16_t, WS_MIX) + (size_t)ML * D, D, 1.0f / sqrtf(256.f * 512.f), (long)CTXL * D};
                  MK_GEMM(EpiStoreBf16, E, WSP(bf16_t, WS_DFT256), 512, WSP(bf16_t, WS_BT2C), 512, 512, CTXL, D, 2, 1, 0, 0, (long)D * 512, 0, CIDR_); }
            } }
            SEAMR(pb + 5, 11); }
            REP(17) {
            { KA_LOAD(); if (IN(pb + 6)) {
                KA_LOAD(); EpiFS2 E{WSP(bf16_t, WS_MIX), 1.0f / sqrtf(4096.f * 512.f)};
                MK_GEMM(EpiFS2, E, WSP(bf16_t, WS_F2MAT), 512, WSP(bf16_t, WS_TW), 8192, 512, 256, D, 32, 16, 0, 0, (long)D * 8192, 512, CID_);
            } }
            SEAMR(pb + 6, 17); }
        }
        REP(15) { const float gsm_ = (rep_ + 1 < NREP(15)) ? 0.f : 1.f;
        { KA_LOAD(); if (IN(pb + 10)) {
            if (ctx_out) { KA_LOAD(); const bf16_t* Wm = even ? WSP(bf16_t, WS_WOUT) + (size_t)j * D * D : WSP(bf16_t, WS_WF) + (size_t)j * D * D;
              EpiPart E{WSP(float, WS_PART), MODL_ + 5 * D, 1.0f * gsm_};
              MK_GEMM(EpiPart, E, WSP(bf16_t, WS_MIX) + (size_t)ML * D, D, Wm, D, 512, MC, D, 4, 1, 512, 0, 512, 0, CIDR_); }
                        { KA_LOAD(); const bf16_t* Wm = even ? WSP(bf16_t, WS_WOUT) + (size_t)j * D * D : WSP(bf16_t, WS_WF) + (size_t)j * D * D;
              EpiResid<false> E{XR_, XR_, MODL_ + 5 * D, 1.0f * gsm_, 0, fusedn ? 1 : 0};
              MK_GEMM(EpiResid<false>, E, WSP(bf16_t, WS_MIX), D, Wm, D, D, ML, D, 1, 1, 0, 0, 0, 0, CID_); }
            if (fusedn && gsm_ != 0.f) { KA_LOAD(); panel_publish(KA, layer * 3 + 2); }

            if (fusedn && gsm_ != 0.f) { KA_LOAD(); panel_norm(F, layer * 3 + 2, NORMG_ + 2 * D, MODL_, 6); }
        } }
        SEAMR(pb + 10, 15); }
        if (!(fusedn && rows_m == ML))
        REP(12) {
        { KA_LOAD(); if (IN(pb + 11)) { KA_LOAD(); ph_norm(F, NORMG_ + 2 * D, MODL_, 6, fusedn ? ML : 0, rows_m, (rep_ + 1 < NREP(12)) ? 0 : (ctx_out ? 4 : 0), XR_, XR_ + (size_t)ML * D); } }
        SEAMR(pb + 11, 12); }
        REP(13) {
        { KA_LOAD(); if (IN(pb + 12)) { KA_LOAD(); EpiSwiglu E{WSP(bf16_t, WS_H)};
            if ((MK_F8_MASK >> (layer * 2 + 1)) & 1) { EpiSwiglu8 E8{WSP(unsigned char, WS_H)}; MK_GEMM(EpiSwiglu8, E8, WSP(bf16_t, WS_XN), D, WSP(bf16_t, WS_W13) + (size_t)(layer * 2 + 1) * 2 * DFF * D, D, D, rows_m, 2 * DFF, 1, 1, 0, 0, 0, 0, CID_); }
            else MK_GEMM(EpiSwiglu, E, WSP(bf16_t, WS_XN), D, WSP(bf16_t, WS_W13) + (size_t)(layer * 2 + 1) * 2 * DFF * D, D, D, rows_m, 2 * DFF, 1, 1, 0, 0, 0, 0, CID_); } }
        SEAMR(pb + 12, 13); }
        REP(16) { const float gsm_ = (rep_ + 1 < NREP(16)) ? 0.f : 1.f;
        { KA_LOAD(); if (IN(pb + 13)) {
            if (ctx_out && (!MK_DUP_LATONLY || gsm_ != 0.f)) { KA_LOAD(); EpiPart E{WSP(float, WS_PART), MODL_ + 8 * D, 0.5f * gsm_};
              if ((MK_F8_MASK >> (layer * 2 + 1)) & 1) MK_GEMM8(EpiPart, E, WSP(unsigned char, WS_H) + (size_t)ML * DFF, DFF / 2, WSP(unsigned char, WS_W28) + (size_t)(layer * 2 + 1) * D * DFF, DFF / 2, 256, MC, D, 11, 256, 256, 127 - F8_SW, 127 - F8_SA, CIDR_);
              else MK_GEMM(EpiPart, E, WSP(bf16_t, WS_H) + (size_t)ML * HP, HP, WSP(bf16_t, WS_W2) + (size_t)(layer * 2 + 1) * D * HP, HP, 512, MC, D, 11, 1, 512, 0, 512, 0, CIDR_); }
                        { KA_LOAD(); float* xo = layer == 3 ? KA->out : XR_;
              EpiResid<false> E{XR_, xo, MODL_ + 8 * D, 0.5f * gsm_, 0, (fusedn && layer < 3) ? 1 : 0};
              if (MK_PROBE_TS0 && gsm_ == 0.f) { pg8::Gemm g_{MK_PROBE_TS0 == 2 ? WSP(bf16_t, WS_CTL + 262144) : WSP(bf16_t, WS_H), MK_PROBE_TS0 == 2 ? WSP(bf16_t, WS_CTL + 262144) : WSP(bf16_t, WS_W2) + (size_t)(layer * 2 + 1) * D * HP, MK_PROBE_TS0 == 2 ? 0 : HP, MK_PROBE_TS0 == 2 ? 0 : HP, MK_PROBE_K, 1, 0, 0, 0, 0, 0, 0, 127, 127}; pg8::Order S_; S_.init(ML, D, 1, G_, CID_); pg8::gemm_phase<EpiResid<false>, true>(F.lds, g_, S_, E); }
              else if ((MK_F8_MASK >> (layer * 2 + 1)) & 1) MK_GEMM8(EpiResid<false>, E, WSP(unsigned char, WS_H), DFF / 2, WSP(unsigned char, WS_W28) + (size_t)(layer * 2 + 1) * D * DFF, DFF / 2, DFF / 2, ML, D, 1, 0, 0, 127 - F8_SW, 127 - F8_SA, CID_);
              else MK_GEMM(EpiResid<false>, E, WSP(bf16_t, WS_H), HP, WSP(bf16_t, WS_W2) + (size_t)(layer * 2 + 1) * D * HP, HP, (gsm_ == 0.f ? MK_PROBE_K : DFF), ML, D, 1, 1, 0, 0, 0, 0, CID_); }
            if (fusedn && layer < 3 && gsm_ != 0.f) { KA_LOAD(); panel_publish(KA, (layer + 1) * 3 + 0); }

            if (fusedn && layer < 3 && gsm_ != 0.f) { KA_LOAD(); panel_norm(F, (layer + 1) * 3 + 0, KA->in[6] + (layer + 1) * 3 * D, WSP(float, WS_MOD) + (size_t)(layer + 1) * 3 * NMOD, 0); }
        } }
        SEAMR(pb + 13, 16); }
    }
#undef IN
#undef SEAM
}
}

#ifndef MK_DUMP_OFF
#define MK_DUMP_OFF mk::WS_XR
#endif
#ifndef MK_PER_PHASE
#define MK_PER_PHASE 0
#endif
extern "C" void kernel_launch(void* const* d_in, const int* in_sizes, int n_in, void* d_out, int out_size, void* d_ws, size_t ws_size, hipStream_t stream) {
    static int grid = 0;
    if (grid == 0) {
        if (n_in != 21 || ws_size < mk::WS_END) { fprintf(stderr, "kernel_launch: unexpected n_in %d / ws %zu (need %zu)\n", n_in, ws_size, (size_t)mk::WS_END); grid = -1; return; }
        int dev = 0, cus = 0, per_cu = 0;
        if (hipGetDevice(&dev) != hipSuccess || hipDeviceGetAttribute(&cus, hipDeviceAttributeMultiprocessorCount, dev) != hipSuccess) { grid = -1; return; }
        if (hipFuncSetAttribute((const void*)mk::mk_fwd, hipFuncAttributeMaxDynamicSharedMemorySize, mk::LDS_BYTES) != hipSuccess) { fprintf(stderr, "kernel_launch: hipFuncSetAttribute failed\n"); grid = -1; return; }
        if (hipOccupancyMaxActiveBlocksPerMultiprocessor(&per_cu, (const void*)mk::mk_fwd, mk::NTHR, mk::LDS_BYTES) != hipSuccess || per_cu < 1) fprintf(stderr, "kernel_launch: occupancy query says %d\n", per_cu);
        (void)hipGetLastError();
        grid = cus;
    }
    if (grid < 0) return;
#ifdef MK_DBG_POISON
    (void)hipMemsetAsync((char*)d_ws, 0xAA, mk::WS_END, stream);
#endif
    (void)hipMemsetAsync((char*)d_ws + mk::WS_CTL, 0, mk::CTL_ZERO_BYTES, stream);
    mk::Args a{};
    for (int i = 0; i < 21; ++i) a.in[i] = (const float*)d_in[i];
    a.out = (float*)d_out; a.ws = (unsigned char*)d_ws;
#if MK_PER_PHASE
    for (int k = 0; k < mk::N_PHASES; ++k) {
        const int loc = (k - 1) % mk::PPL, layer = (k - 1) / mk::PPL;
        if (k > 0 && (layer & 1) && (loc >= 7 && loc <= 9)) continue;
        a.ph_lo = k; a.ph_hi = k + 1;
        hipLaunchKernelGGL(mk::mk_fwd, dim3(grid), dim3(mk::NTHR), mk::LDS_BYTES, stream, a);
#ifdef MK_STOP_AFTER
        if (k == MK_STOP_AFTER) { (void)hipMemcpyAsync(d_out, (char*)d_ws + MK_DUMP_OFF, (size_t)mk::ML * mk::D * 4, hipMemcpyDeviceToDevice, stream); break; }
#endif
    }
#else
    a.ph_lo = 0; a.ph_hi = mk::N_PHASES;
    hipLaunchKernelGGL(mk::mk_fwd, dim3(grid), dim3(mk::NTHR), mk::LDS_BYTES, stream, a);
#endif
}
```
